# Optimizing an MI355X kernel written in HIP

```python
import jax, jax.numpy as jnp
from jax import lax
import numpy as np

D_MODEL = 1024
BATCH = 2
SEQ = 8192
DEPTH = 4

POOL_WINDOWS = (2, 4, 8, 16)
POOL_GROUPS = 4
POOL_GC = 64
POOL_W = POOL_GROUPS * POOL_GC
M_HEADS = 4
M_DH = 64
M_W = M_HEADS * M_DH
M_CONV = 4
M_CHUNK = 128
A_HEADS = 8
A_DH = 64
A_W = A_HEADS * A_DH
MOBA_BLOCK = 256
MOBA_TOPK = 3
Q_BLOCK = 128
MIX_W = POOL_W + M_W + A_W
OFF_MQK = POOL_W
OFF_MV = OFF_MQK + 2 * M_W
OFF_MO = OFF_MV + M_W
OFF_MI = OFF_MO + M_W
OFF_MF = OFF_MI + M_HEADS
OFF_A = OFF_MF + M_HEADS
IN_W = OFF_A + 3 * A_W
D_FF = 2816
FFN_CONV = 3
EPS = 1e-6

kernel_name = 'hybrid_pool_mlstm_moba_convffn'


def rmsnorm(x, g):
    xf = x.astype(jnp.float32)
    y = xf * lax.rsqrt(jnp.mean(xf * xf, axis=-1, keepdims=True) + EPS) * g.astype(jnp.float32)
    return y.astype(x.dtype)


def causal_dwconv(x, w):
    K = w.shape[0]
    S = x.shape[1]
    xp = jnp.pad(x, ((0, 0), (K - 1, 0), (0, 0)))
    y = xp[:, 0:S] * w[0]
    for j in range(1, K):
        y = y + xp[:, j:j + S] * w[j]
    return y


def pool_mixer(xp, w_pool, scale):
    B, S, _ = xp.shape
    xg = xp.astype(jnp.float32).reshape(B, S, POOL_GROUPS, POOL_GC)
    cs = jnp.concatenate([jnp.zeros((B, 1, POOL_GROUPS, POOL_GC), jnp.float32), jnp.cumsum(xg, axis=1)], axis=1)
    t = jnp.arange(S)
    outs = []
    for g, w in enumerate(POOL_WINDOWS):
        lo = jnp.maximum(t + 1 - w, 0)
        cnt = (t + 1 - lo).astype(jnp.float32)
        win_sum = cs[:, 1:, g] - cs[:, lo, g]
        outs.append(win_sum / cnt[None, :, None] - xg[:, :, g])
    d = jnp.stack(outs, axis=2)
    y = jnp.einsum('bsgc,gcd->bsgd', d, w_pool.astype(jnp.float32)).reshape(B, S, POOL_W)
    return y * scale.astype(jnp.float32)


def mlstm_chunkwise(q, k, v, i_pre, f_pre):
    B, S, H, Dh = q.shape
    L = M_CHUNK
    NC = S // L
    def ch5(t):
        return t.reshape(B, NC, L, H, Dh).transpose(1, 0, 3, 2, 4)
    def ch4(t):
        return t.reshape(B, NC, L, H).transpose(1, 0, 3, 2)
    logf = jax.nn.log_sigmoid(f_pre)
    causal = jnp.tril(jnp.ones((L, L), dtype=bool))

    def step(carry, inp):
        C, n, m = carry
        qc, kc, vc, ic, lf = inp
        g = jnp.cumsum(lf, axis=-1)
        logd = jnp.where(causal, g[..., :, None] - g[..., None, :] + ic[..., None, :], -jnp.inf)
        inter = g + m[..., None]
        mt = jnp.maximum(inter, jnp.max(logd, axis=-1))
        w = jnp.einsum('bhtd,bhsd->bhts', qc, kc) * jnp.exp(logd - mt[..., None])
        a = jnp.exp(inter - mt)
        num = jnp.einsum('bhts,bhse->bhte', w, vc) + a[..., None] * jnp.einsum('bhtd,bhde->bhte', qc, C)
        den = jnp.sum(w, axis=-1) + a * jnp.einsum('bhtd,bhd->bht', qc, n)
        hc = num / jnp.maximum(jnp.abs(den), jnp.exp(-mt))[..., None]
        gl = g[..., -1]
        wl = gl[..., None] - g + ic
        m_new = jnp.maximum(gl + m, jnp.max(wl, axis=-1))
        wk = jnp.exp(wl - m_new[..., None])
        dec = jnp.exp(gl + m - m_new)
        C = dec[..., None, None] * C + jnp.einsum('bhs,bhsd,bhse->bhde', wk, kc, vc)
        n = dec[..., None] * n + jnp.einsum('bhs,bhsd->bhd', wk, kc)
        return (C, n, m_new), hc

    init = (jnp.zeros((B, H, Dh, Dh), jnp.float32), jnp.zeros((B, H, Dh), jnp.float32), jnp.zeros((B, H), jnp.float32))
    _, hs = lax.scan(step, init, (ch5(q), ch5(k), ch5(v), ch4(i_pre), ch4(logf)))
    return hs.transpose(1, 0, 3, 2, 4).reshape(B, S, H, Dh)


def moba_attention(q, k, v):
    q = q.astype(jnp.float32).transpose(0, 2, 1, 3)
    k = k.astype(jnp.float32).transpose(0, 2, 1, 3)
    v = v.astype(jnp.float32).transpose(0, 2, 1, 3)
    B, H, S, Dh = q.shape
    NB = -(-S // MOBA_BLOCK)
    pad = NB * MOBA_BLOCK - S
    kp = jnp.pad(k, ((0, 0), (0, 0), (0, pad), (0, 0)))
    vp = jnp.pad(v, ((0, 0), (0, 0), (0, pad), (0, 0)))
    kb = kp.reshape(B, H, NB, MOBA_BLOCK, Dh)
    vb = vp.reshape(B, H, NB, MOBA_BLOCK, Dh)
    kmean = jnp.mean(kb, axis=3)
    topk = min(MOBA_TOPK, NB)
    NQ = S // Q_BLOCK
    scale = A_DH ** -0.5
    qs = q.reshape(B, H, NQ, Q_BLOCK, Dh).transpose(2, 0, 1, 3, 4)
    bi = jnp.arange(B)[:, None, None, None]
    hi = jnp.arange(H)[None, :, None, None]
    blk_ids = jnp.arange(NB)

    def one(args):
        qi, ci = args
        q0 = ci * Q_BLOCK
        own = q0 // MOBA_BLOCK
        gate = jnp.einsum('bhqd,bhnd->bhqn', qi, kmean)
        gate = jnp.where((blk_ids < own)[None, None, None, :], gate, -jnp.inf)
        gval, gidx = lax.top_k(gate, topk)
        valid = jnp.isfinite(gval)
        ksel = kb[bi, hi, gidx]
        vsel = vb[bi, hi, gidx]
        s_sel = jnp.einsum('bhqd,bhqjkd->bhqjk', qi, ksel) * scale
        s_sel = jnp.where(valid[..., None], s_sel, -jnp.inf).reshape(B, H, Q_BLOCK, topk * MOBA_BLOCK)
        k_own = lax.dynamic_slice_in_dim(kp, own * MOBA_BLOCK, MOBA_BLOCK, axis=2)
        v_own = lax.dynamic_slice_in_dim(vp, own * MOBA_BLOCK, MOBA_BLOCK, axis=2)
        s_own = jnp.einsum('bhqd,bhkd->bhqk', qi, k_own) * scale
        kpos = own * MOBA_BLOCK + jnp.arange(MOBA_BLOCK)
        qpos = q0 + jnp.arange(Q_BLOCK)
        s_own = jnp.where((kpos[None, :] <= qpos[:, None])[None, None], s_own, -jnp.inf)
        p = jax.nn.softmax(jnp.concatenate([s_sel, s_own], axis=-1), axis=-1)
        p_sel = p[..., :topk * MOBA_BLOCK].reshape(B, H, Q_BLOCK, topk, MOBA_BLOCK)
        p_own = p[..., topk * MOBA_BLOCK:]
        return jnp.einsum('bhqjk,bhqjkd->bhqd', p_sel, vsel) + jnp.einsum('bhqk,bhkd->bhqd', p_own, v_own)

    outs = lax.map(one, (qs, jnp.arange(NQ)))
    return outs.transpose(1, 0, 3, 2, 4).reshape(B, S, H, Dh)


def setup_inputs(seed: int = 0) -> dict:
    key = jax.random.key(seed)
    ks = jax.random.split(key, 18)
    nrm = jax.random.normal
    f32 = jnp.float32
    return {
        'x': nrm(ks[0], (BATCH, SEQ, D_MODEL), f32),
        'ln1_g': 1.0 + 0.02 * nrm(ks[1], (DEPTH, D_MODEL), f32),
        'w_in': nrm(ks[2], (DEPTH, D_MODEL, IN_W), f32) * D_MODEL ** -0.5,
        'pool_w': nrm(ks[3], (DEPTH, POOL_GROUPS, POOL_GC, POOL_GC), f32) * POOL_GC ** -0.5,
        'pool_scale': 1.0 + 0.1 * nrm(ks[4], (DEPTH, POOL_W), f32),
        'm_conv': nrm(ks[5], (DEPTH, M_CONV, 2 * M_W), f32) * M_CONV ** -0.5,
        'm_b_i': 0.1 * nrm(ks[6], (DEPTH, M_HEADS), f32),
        'm_b_f': jnp.linspace(3.0, 6.0, M_HEADS, dtype=f32)[None, :] + 0.01 * nrm(ks[7], (DEPTH, M_HEADS), f32),
        'm_norm_g': 1.0 + 0.02 * nrm(ks[8], (DEPTH, M_W), f32),
        'a_q_g': 1.0 + 0.02 * nrm(ks[9], (DEPTH, A_DH), f32),
        'a_k_g': 1.0 + 0.02 * nrm(ks[10], (DEPTH, A_DH), f32),
        'w_out': nrm(ks[11], (DEPTH, MIX_W, D_MODEL), f32) * MIX_W ** -0.5,
        'ln2_g': 1.0 + 0.02 * nrm(ks[12], (DEPTH, D_MODEL), f32),
        'w_up': nrm(ks[13], (DEPTH, D_MODEL, 2 * D_FF), f32) * D_MODEL ** -0.5,
        'ffn_conv': nrm(ks[14], (DEPTH, FFN_CONV, 2 * D_FF), f32) * FFN_CONV ** -0.5,
        'w_down': nrm(ks[15], (DEPTH, D_FF, D_MODEL), f32) * D_FF ** -0.5,
    }


def reference(x, ln1_g, w_in, pool_w, pool_scale, m_conv, m_b_i, m_b_f, m_norm_g,
              a_q_g, a_k_g, w_out, ln2_g, w_up, ffn_conv, w_down):
    B, S, _ = x.shape
    for l in range(DEPTH):
        h = rmsnorm(x, ln1_g[l])
        z = h @ w_in[l]
        po = pool_mixer(z[..., :OFF_MQK], pool_w[l], pool_scale[l])
        qk = jax.nn.silu(causal_dwconv(z[..., OFF_MQK:OFF_MV], m_conv[l])).astype(jnp.float32)
        mq = qk[..., :M_W].reshape(B, S, M_HEADS, M_DH)
        mk = qk[..., M_W:].reshape(B, S, M_HEADS, M_DH) * (M_DH ** -0.5)
        mv = z[..., OFF_MV:OFF_MO].astype(jnp.float32).reshape(B, S, M_HEADS, M_DH)
        mo = jax.nn.sigmoid(z[..., OFF_MO:OFF_MI])
        mi = (z[..., OFF_MI:OFF_MF] + m_b_i[l]).astype(jnp.float32)
        mf = (z[..., OFF_MF:OFF_A] + m_b_f[l]).astype(jnp.float32)
        hm = mlstm_chunkwise(mq, mk, mv, mi, mf)
        hm = rmsnorm(hm, m_norm_g[l].reshape(M_HEADS, M_DH)).reshape(B, S, M_W).astype(x.dtype) * mo
        aq = rmsnorm(z[..., OFF_A:OFF_A + A_W].reshape(B, S, A_HEADS, A_DH), a_q_g[l])
        ak = rmsnorm(z[..., OFF_A + A_W:OFF_A + 2 * A_W].reshape(B, S, A_HEADS, A_DH), a_k_g[l])
        av = z[..., OFF_A + 2 * A_W:].reshape(B, S, A_HEADS, A_DH)
        ao = moba_attention(aq, ak, av).reshape(B, S, A_W)
        mix = jnp.concatenate([po.astype(x.dtype), hm, ao.astype(x.dtype)], axis=-1)
        x = x + mix @ w_out[l]
        h2 = rmsnorm(x, ln2_g[l])
        u = causal_dwconv(h2 @ w_up[l], ffn_conv[l])
        x = x + (jax.nn.silu(u[..., :D_FF]) * u[..., D_FF:]) @ w_down[l]
    return x
```

```cpp
#include <hip/hip_runtime.h>
#include <cstdint>
#include <cstdio>

typedef unsigned short bf16;
typedef unsigned v4u __attribute__((ext_vector_type(4)));
typedef float f32x4 __attribute__((ext_vector_type(4)));

constexpr int BATCH = 2, SEQ = 8192, DM = 1024, DEPTH = 4, M = BATCH * SEQ;
constexpr int IN_W = 2824, NIN = 3072, ZP = 2816, DFF = 2816, NUP = 5632;
constexpr float EPS = 1e-6f;
constexpr float C2 = 0.125f * 1.4426950408889634f;
constexpr int ZC_AQ = 0, ZC_AK = 512, ZC_AV = 1024, ZC_POOL = 1536, ZC_MQ = 1792, ZC_MK = 2048, ZC_MV = 2304, ZC_MO = 2560, ZC_GATE = 2816;
constexpr int MC_POOL = 0, MC_ML = 256, MC_AT = 512;

constexpr size_t MiB = 1u << 20;
constexpr size_t WS_CTL = 0;
constexpr size_t WS_WIN = 1 * MiB;
constexpr size_t WS_WOUT = 25 * MiB;
constexpr size_t WS_WUP = 33 * MiB;
constexpr size_t WS_WDOWN = 77 * MiB;
constexpr size_t WS_XB = 99 * MiB;
constexpr size_t WS_Z = 131 * MiB;
constexpr size_t WS_MIX = 219 * MiB;
constexpr size_t WS_GATES = 251 * MiB;
constexpr size_t WS_ROWSQ = 252 * MiB;
constexpr size_t WS_KPART = 253 * MiB;
constexpr size_t WS_QKC = 254 * MiB;
constexpr size_t WS_END = 286 * MiB;

__host__ __device__ __forceinline__ unsigned f2bf(float f) { unsigned u = __builtin_bit_cast(unsigned, f); return (u + 0x7fffu + ((u >> 16) & 1u)) >> 16; }
__device__ __forceinline__ float bf2f(unsigned b) { return __builtin_bit_cast(float, (b & 0xffffu) << 16); }
__device__ __forceinline__ unsigned pk2(float lo, float hi) { return f2bf(lo) | (f2bf(hi) << 16); }
__device__ __forceinline__ float sigmoidf_(float x) { return 1.f / (1.f + __expf(-x)); }
__device__ __forceinline__ float siluf_(float x) { return x / (1.f + __expf(-x)); }
__device__ __forceinline__ float wave_sum(float v) {
#pragma unroll
    for (int o = 1; o < 64; o <<= 1) v += __shfl_xor(v, o);
    return v;
}
__device__ __forceinline__ float wave_max(float v) {
#pragma unroll
    for (int o = 1; o < 64; o <<= 1) v = fmaxf(v, __shfl_xor(v, o));
    return v;
}

__host__ __device__ __forceinline__ int in_orig_col(int zc) { return zc < 1536 ? 1288 + zc : (zc < 2816 ? zc - 1536 : (zc < 2824 ? 1280 + (zc - 2816) : -1)); }
__host__ __device__ __forceinline__ int in_row_to_zc(int r) { const int pn = r >> 8, s = r & 255; return 256 * pn + 64 * ((s >> 5) & 3) + 32 * (s >> 7) + (s & 31); }
__host__ __device__ __forceinline__ int up_row_to_orig(int r) { const int pn = r >> 8, s = r & 255; return (s >> 7) * DFF + 128 * pn + (s & 127); }

template <int MODE  > __global__ void __launch_bounds__(256) prep_w(const float* __restrict__ W, const float* __restrict__ gain, bf16* __restrict__ out, int K, int Norig, int Nout) {
    __shared__ float t[64][65];
    const int l = blockIdx.z; W += (size_t)l * K * Norig; out += (size_t)l * Nout * K; if (gain) gain += (size_t)l * K;
    const int r0 = blockIdx.x * 64, k0 = blockIdx.y * 64, tid = threadIdx.x;
    { const int r = tid & 63; const int rr = r0 + r; int oc;
      if (MODE == 0) oc = in_orig_col(in_row_to_zc(rr)); else if (MODE == 2) oc = up_row_to_orig(rr); else oc = rr;
#pragma unroll 4
      for (int it = 0; it < 16; ++it) { const int kk = (tid >> 6) + 4 * it; float v = 0.f; if (oc >= 0) { v = W[(size_t)(k0 + kk) * Norig + oc]; if (gain) v *= gain[k0 + kk]; } t[kk][r] = v; } }
    __syncthreads();
#pragma unroll
    for (int it = 0; it < 2; ++it) { const int r = (tid >> 3) + 32 * it, k8 = (tid & 7) * 8; v4u o;
        o.x = pk2(t[k8 + 0][r], t[k8 + 1][r]); o.y = pk2(t[k8 + 2][r], t[k8 + 3][r]); o.z = pk2(t[k8 + 4][r], t[k8 + 5][r]); o.w = pk2(t[k8 + 6][r], t[k8 + 7][r]);
        *(v4u*)(out + (size_t)(r0 + r) * K + k0 + k8) = o; }
}
__global__ void __launch_bounds__(256) prep_x(const float* __restrict__ x, float* __restrict__ X, bf16* __restrict__ XB, float* __restrict__ rowsq) {
    const int row = blockIdx.x * 4 + (threadIdx.x >> 6), lane = threadIdx.x & 63; float s = 0.f;
#pragma unroll
    for (int j = 0; j < 4; ++j) { const f32x4 v = *(const f32x4*)(x + (size_t)row * DM + 256 * j + 4 * lane); *(f32x4*)(X + (size_t)row * DM + 256 * j + 4 * lane) = v;
        s += v.x * v.x + v.y * v.y + v.z * v.z + v.w * v.w; uint2 o; o.x = pk2(v.x, v.y); o.y = pk2(v.z, v.w); *(uint2*)(XB + (size_t)row * DM + 256 * j + 4 * lane) = o; }
    s = wave_sum(s); if (lane == 0) *(f32x4*)(rowsq + 4 * row) = (f32x4){s, 0.f, 0.f, 0.f};
}
__global__ void __launch_bounds__(256) rowsq_naive(const float* __restrict__ X, float* __restrict__ rowsq) {
    const int row = blockIdx.x * 4 + (threadIdx.x >> 6), lane = threadIdx.x & 63; float s = 0.f;
#pragma unroll
    for (int j = 0; j < 4; ++j) { const f32x4 v = *(const f32x4*)(X + (size_t)row * DM + 256 * j + 4 * lane); s += v.x * v.x + v.y * v.y + v.z * v.z + v.w * v.w; }
    s = wave_sum(s); if (lane == 0) *(f32x4*)(rowsq + 4 * row) = (f32x4){s, 0.f, 0.f, 0.f};
}

struct GArgs { const bf16* A; int lda; const bf16* Bt; int K; const float* rowsq; float* X; bf16* XB; bf16* Z; float* gates; const float* b_i; const float* b_f; bf16* hact; const float* fconv; };
template <int MODE> __global__ void __launch_bounds__(256) gemm_naive(GArgs g) {
    __shared__ float As[32][65], Bs[32][65], Bs2[MODE == 2 ? 32 : 1][65], Cs[64][65], Cs2[MODE == 2 ? 64 : 1][65];
    const int tid = threadIdx.x, tx = tid & 15, ty = tid >> 4;
    int rowbase, t0 = 0, c0;
    if (MODE == 2) { const int b = blockIdx.x / 133, tb = blockIdx.x % 133; t0 = tb * 62 - 2; rowbase = b * SEQ + t0; const int ct = blockIdx.y; c0 = 256 * (ct >> 1) + 64 * (ct & 1); }
    else { rowbase = blockIdx.x * 64; c0 = blockIdx.y * 64; }
    float acc[4][4], acc2[4][4];
#pragma unroll
    for (int i = 0; i < 4; ++i)
#pragma unroll
        for (int j = 0; j < 4; ++j) { acc[i][j] = 0.f; acc2[i][j] = 0.f; }
    const int li = tid >> 2, kc = (tid & 3) * 8;
    const bool avalid = (MODE != 2) || (t0 + li >= 0 && t0 + li < SEQ);
    const bf16* ap = g.A + (size_t)(rowbase + li) * g.lda + kc;
    const bf16* bp = g.Bt + (size_t)(c0 + li) * g.K + kc;
    for (int k0 = 0; k0 < g.K; k0 += 32) {
        v4u av = (v4u){0u, 0u, 0u, 0u}; if (avalid) av = *(const v4u*)(ap + k0);
        const v4u bv = *(const v4u*)(bp + k0);
        v4u bv2 = (v4u){0u, 0u, 0u, 0u}; if (MODE == 2) bv2 = *(const v4u*)(bp + (size_t)128 * g.K + k0);
        __syncthreads();
        As[kc + 0][li] = bf2f(av.x); As[kc + 1][li] = bf2f(av.x >> 16); As[kc + 2][li] = bf2f(av.y); As[kc + 3][li] = bf2f(av.y >> 16);
        As[kc + 4][li] = bf2f(av.z); As[kc + 5][li] = bf2f(av.z >> 16); As[kc + 6][li] = bf2f(av.w); As[kc + 7][li] = bf2f(av.w >> 16);
        Bs[kc + 0][li] = bf2f(bv.x); Bs[kc + 1][li] = bf2f(bv.x >> 16); Bs[kc + 2][li] = bf2f(bv.y); Bs[kc + 3][li] = bf2f(bv.y >> 16);
        Bs[kc + 4][li] = bf2f(bv.z); Bs[kc + 5][li] = bf2f(bv.z >> 16); Bs[kc + 6][li] = bf2f(bv.w); Bs[kc + 7][li] = bf2f(bv.w >> 16);
        if (MODE == 2) {
            Bs2[kc + 0][li] = bf2f(bv2.x); Bs2[kc + 1][li] = bf2f(bv2.x >> 16); Bs2[kc + 2][li] = bf2f(bv2.y); Bs2[kc + 3][li] = bf2f(bv2.y >> 16);
            Bs2[kc + 4][li] = bf2f(bv2.z); Bs2[kc + 5][li] = bf2f(bv2.z >> 16); Bs2[kc + 6][li] = bf2f(bv2.w); Bs2[kc + 7][li] = bf2f(bv2.w >> 16); }
        __syncthreads();
#pragma unroll 8
        for (int kk = 0; kk < 32; ++kk) {
            float a[4], b[4], b2[4];
#pragma unroll
            for (int i = 0; i < 4; ++i) { a[i] = As[kk][4 * ty + i]; b[i] = Bs[kk][4 * tx + i]; b2[i] = (MODE == 2) ? Bs2[kk][4 * tx + i] : 0.f; }
#pragma unroll
            for (int i = 0; i < 4; ++i)
#pragma unroll
                for (int j = 0; j < 4; ++j) { acc[i][j] += a[i] * b[j]; if (MODE == 2) acc2[i][j] += a[i] * b2[j]; }
        }
    }
#pragma unroll
    for (int i = 0; i < 4; ++i) { const int r = 4 * ty + i; float sc = 1.f;
        if (MODE != 1) { const bool v = (MODE != 2) || (t0 + r >= 0 && t0 + r < SEQ); if (v) { const f32x4 q = *(const f32x4*)(g.rowsq + 4 * (size_t)(rowbase + r)); sc = rsqrtf((q.x + q.y + q.z + q.w) * (1.f / DM) + EPS); } else sc = 0.f; }
#pragma unroll
        for (int j = 0; j < 4; ++j) { Cs[r][4 * tx + j] = acc[i][j] * sc; if (MODE == 2) Cs2[r][4 * tx + j] = acc2[i][j] * sc; } }
    __syncthreads();
    const int j = tid & 63;
    if (MODE == 0) {
        const int zc = in_row_to_zc(c0 + j);
#pragma unroll 4
        for (int it = 0; it < 16; ++it) { const int i = (tid >> 6) + 4 * it; const size_t row = rowbase + i; float v = Cs[i][j];
            if (zc < ZC_GATE) { if (zc >= ZC_MO) v = sigmoidf_(v); g.Z[row * ZP + zc] = (bf16)f2bf(v); }
            else if (zc < ZC_GATE + 8) { const int gi = zc - ZC_GATE; g.gates[row * 8 + gi] = v + (gi < 4 ? g.b_i[gi] : g.b_f[gi - 4]); } }
    } else if (MODE == 1) {
#pragma unroll 4
        for (int it = 0; it < 16; ++it) { const int i = (tid >> 6) + 4 * it; const size_t o = (size_t)(rowbase + i) * DM + c0 + j; const float v = g.X[o] + Cs[i][j]; g.X[o] = v; g.XB[o] = (bf16)f2bf(v); }
    } else {
        const int ch = 128 * (blockIdx.y >> 1) + 64 * (blockIdx.y & 1) + j;
        const float wg0 = g.fconv[ch], wg1 = g.fconv[NUP + ch], wg2 = g.fconv[2 * NUP + ch];
        const float wu0 = g.fconv[DFF + ch], wu1 = g.fconv[NUP + DFF + ch], wu2 = g.fconv[2 * NUP + DFF + ch];
        for (int it = 0; it < 16; ++it) { const int i = (tid >> 6) + 4 * it; if (i < 2 || t0 + i >= SEQ) continue;
            const float ug = wg0 * Cs[i - 2][j] + wg1 * Cs[i - 1][j] + wg2 * Cs[i][j], uu = wu0 * Cs2[i - 2][j] + wu1 * Cs2[i - 1][j] + wu2 * Cs2[i][j];
            g.hact[(size_t)(rowbase + i) * DFF + ch] = (bf16)f2bf(siluf_(ug) * uu); }
    }
}

__global__ void __launch_bounds__(256) qknorm_naive(bf16* __restrict__ Z, const float* __restrict__ gq, const float* __restrict__ gk) {
    const int w = blockIdx.x * 4 + (threadIdx.x >> 6), lane = threadIdx.x & 63, row = w >> 4, hs = w & 15;
    bf16* p = Z + (size_t)row * ZP + (hs < 8 ? ZC_AQ + 64 * hs : ZC_AK + 64 * (hs - 8)) + lane;
    const float v = bf2f(*p); const float ss = wave_sum(v * v); const float r = rsqrtf(ss * (1.f / 64.f) + EPS);
    *p = (bf16)f2bf(hs < 8 ? v * r * gq[lane] * C2 : v * r * gk[lane]);
}
__global__ void __launch_bounds__(64) kmean_naive(const bf16* __restrict__ Z, float* __restrict__ kpart) {
    const int bh = blockIdx.x >> 5, n = blockIdx.x & 31, b = bh >> 3, h = bh & 7, d = threadIdx.x; float s = 0.f;
    for (int i = 0; i < 256; ++i) s += bf2f(Z[(size_t)(b * SEQ + n * 256 + i) * ZP + ZC_AK + 64 * h + d]);
    kpart[((size_t)blockIdx.x * 2 + 0) * 64 + d] = s; kpart[((size_t)blockIdx.x * 2 + 1) * 64 + d] = 0.f;
}
__global__ void __launch_bounds__(256) attn_naive(const bf16* __restrict__ Z, const float* __restrict__ kpart, bf16* __restrict__ mix) {
    __shared__ float qs[4][64]; __shared__ float ps[4][1024];
    const int wv = threadIdx.x >> 6, lane = threadIdx.x & 63; const int w = blockIdx.x * 4 + wv; const int row = w >> 3, h = w & 7, b = row / SEQ, t = row % SEQ, own = t >> 8;
    qs[wv][lane] = bf2f(Z[(size_t)row * ZP + ZC_AQ + 64 * h + lane]);
    __syncthreads();
    float gate = -INFINITY;
    if (lane < own) { const float* kp = kpart + ((size_t)((b * 8 + h) * 32 + lane) * 2) * 64; float s = 0.f; for (int d = 0; d < 64; ++d) s += qs[wv][d] * (kp[d] + kp[64 + d]); gate = s * (1.f / 256.f); }
    int blk[4]; bool val[4];
#pragma unroll
    for (int j = 0; j < 3; ++j) { const float mx = wave_max(gate); val[j] = mx > -INFINITY; const unsigned long long bal = __ballot(gate == mx); const int idx = val[j] ? (int)__builtin_ctzll(bal) : 0; blk[j] = idx; if (lane == idx) gate = -INFINITY; }
    blk[3] = own; val[3] = true;
    float sc[4][4]; float mx = -INFINITY;
#pragma unroll
    for (int j = 0; j < 4; ++j)
#pragma unroll
        for (int i = 0; i < 4; ++i) { const int key = lane + 64 * i, pos = blk[j] * 256 + key; float s = -INFINITY;
            if (val[j] && (j < 3 || pos <= t)) { const bf16* kp = Z + (size_t)(b * SEQ + pos) * ZP + ZC_AK + 64 * h; s = 0.f;
                for (int c = 0; c < 8; ++c) { const v4u kv = *(const v4u*)(kp + 8 * c); const float* qq = &qs[wv][8 * c];
                    s += qq[0] * bf2f(kv.x) + qq[1] * bf2f(kv.x >> 16) + qq[2] * bf2f(kv.y) + qq[3] * bf2f(kv.y >> 16) + qq[4] * bf2f(kv.z) + qq[5] * bf2f(kv.z >> 16) + qq[6] * bf2f(kv.w) + qq[7] * bf2f(kv.w >> 16); } }
            sc[j][i] = s; mx = fmaxf(mx, s); }
    mx = wave_max(mx); float sum = 0.f;
#pragma unroll
    for (int j = 0; j < 4; ++j)
#pragma unroll
        for (int i = 0; i < 4; ++i) { const float p = exp2f(sc[j][i] - mx); sum += p; ps[wv][j * 256 + lane + 64 * i] = p; }
    sum = wave_sum(sum);
    __syncthreads();
    float o = 0.f;
#pragma unroll
    for (int j = 0; j < 4; ++j) { if (!val[j]) continue; const bf16* vp = Z + (size_t)(b * SEQ + blk[j] * 256) * ZP + ZC_AV + 64 * h + lane;
        for (int i = 0; i < 256; ++i) o += ps[wv][j * 256 + i] * bf2f(vp[(size_t)i * ZP]); }
    mix[(size_t)row * DM + MC_AT + 64 * h + lane] = (bf16)f2bf(o / sum);
}
__global__ void __launch_bounds__(256) pool_naive(const bf16* __restrict__ Z, const float* __restrict__ pw, const float* __restrict__ pscale, bf16* __restrict__ mix) {
    __shared__ float dsh[256];
    const int row = blockIdx.x, t = row % SEQ, tid = threadIdx.x, g = tid >> 6, c = tid & 63; const int win = 2 << g;
    const int lo = (t + 1 - win) > 0 ? (t + 1 - win) : 0; float s = 0.f;
    for (int u = lo; u <= t; ++u) s += bf2f(Z[(size_t)(row - t + u) * ZP + ZC_POOL + tid]);
    dsh[tid] = s / (float)(t + 1 - lo) - bf2f(Z[(size_t)row * ZP + ZC_POOL + tid]);
    __syncthreads();
    float y = 0.f; for (int k = 0; k < 64; ++k) y += dsh[g * 64 + k] * pw[(size_t)(g * 64 + k) * 64 + c];
    mix[(size_t)row * DM + MC_POOL + tid] = (bf16)f2bf(y * pscale[tid]);
}
__global__ void __launch_bounds__(256) mconv_naive(const bf16* __restrict__ Z, const float* __restrict__ cw, float* __restrict__ qkc) {
    const size_t idx = (size_t)blockIdx.x * 256 + threadIdx.x; const int row = (int)(idx >> 9), c = (int)(idx & 511), t = row % SEQ; float s = 0.f;
#pragma unroll
    for (int j = 0; j < 4; ++j) { const int tt = t - 3 + j; if (tt >= 0) s += cw[j * 512 + c] * bf2f(Z[(size_t)(row - 3 + j) * ZP + ZC_MQ + c]); }
    s = siluf_(s); qkc[idx] = c < 256 ? s : s * 0.125f;
}
__global__ void __launch_bounds__(256) mlstm_naive(const float* __restrict__ qkc, const bf16* __restrict__ Z, const float* __restrict__ gates, const float* __restrict__ ng, bf16* __restrict__ mix) {
    __shared__ float qsh[64], ksh[64], pnum[4][64], pden[4];
    const int bh = blockIdx.x, b = bh >> 2, h = bh & 3, tid = threadIdx.x, e = tid & 63, dg = tid >> 6;
    float C[16], nn[16];
#pragma unroll
    for (int i = 0; i < 16; ++i) { C[i] = 0.f; nn[i] = 0.f; }
    float m = 0.f; const float gn = ng[h * 64 + e];
    for (int t = 0; t < SEQ; ++t) {
        const size_t row = (size_t)b * SEQ + t;
        if (tid < 64) qsh[tid] = qkc[row * 512 + h * 64 + tid]; else if (tid < 128) ksh[tid - 64] = qkc[row * 512 + 256 + h * 64 + (tid - 64)];
        const float v = bf2f(Z[row * ZP + ZC_MV + h * 64 + e]); const float ip = gates[row * 8 + h], fp = gates[row * 8 + 4 + h];
        const float logf = fminf(fp, 0.f) - log1pf(__expf(-fabsf(fp)));
        const float mn = fmaxf(logf + m, ip), fs = __expf(logf + m - mn), is = __expf(ip - mn); m = mn;
        __syncthreads();
        float pn = 0.f, pd = 0.f;
#pragma unroll
        for (int i = 0; i < 16; ++i) { const float kd = ksh[16 * dg + i], qd = qsh[16 * dg + i]; C[i] = fs * C[i] + is * kd * v; nn[i] = fs * nn[i] + is * kd; pn += qd * C[i]; pd += qd * nn[i]; }
        pnum[dg][e] = pn; if (e == 0) pden[dg] = pd;
        __syncthreads();
        if (tid < 64) { const float num = pnum[0][e] + pnum[1][e] + pnum[2][e] + pnum[3][e], den = pden[0] + pden[1] + pden[2] + pden[3];
            const float hh = num / fmaxf(fabsf(den), __expf(-mn)); const float ss = wave_sum(hh * hh);
            const float o = hh * rsqrtf(ss * (1.f / 64.f) + EPS) * gn * bf2f(Z[row * ZP + ZC_MO + h * 64 + e]);
            mix[row * DM + MC_ML + h * 64 + e] = (bf16)f2bf(o); }
    }
}

extern "C" void kernel_launch(void* const* d_in, const int* in_sizes, int n_in, void* d_out, int out_size, void* d_ws, size_t ws_size, hipStream_t stream) {
    if (n_in != 16 || out_size != M * DM || ws_size < WS_END) { fprintf(stderr, "kernel_launch: unexpected shapes (n_in %d out %d ws %zu)\n", n_in, out_size, ws_size); return; }
    const float* x = (const float*)d_in[0]; const float* ln1 = (const float*)d_in[1]; const float* w_in = (const float*)d_in[2]; const float* pool_w = (const float*)d_in[3];
    const float* pool_scale = (const float*)d_in[4]; const float* m_conv = (const float*)d_in[5]; const float* m_b_i = (const float*)d_in[6]; const float* m_b_f = (const float*)d_in[7];
    const float* m_norm_g = (const float*)d_in[8]; const float* a_q_g = (const float*)d_in[9]; const float* a_k_g = (const float*)d_in[10]; const float* w_out = (const float*)d_in[11];
    const float* ln2 = (const float*)d_in[12]; const float* w_up = (const float*)d_in[13]; const float* ffn_conv = (const float*)d_in[14]; const float* w_down = (const float*)d_in[15];
    unsigned char* ws = (unsigned char*)d_ws; float* X = (float*)d_out;
    bf16* Win = (bf16*)(ws + WS_WIN); bf16* Wout = (bf16*)(ws + WS_WOUT); bf16* Wup = (bf16*)(ws + WS_WUP); bf16* Wdown = (bf16*)(ws + WS_WDOWN);
    bf16* XB = (bf16*)(ws + WS_XB); bf16* Z = (bf16*)(ws + WS_Z); bf16* HACT = Z; bf16* MIX = (bf16*)(ws + WS_MIX);
    float* GATES = (float*)(ws + WS_GATES); float* ROWSQ = (float*)(ws + WS_ROWSQ); float* KPART = (float*)(ws + WS_KPART); float* QKC = (float*)(ws + WS_QKC);

    prep_w<0><<<dim3(NIN / 64, DM / 64, DEPTH), 256, 0, stream>>>(w_in, ln1, Win, DM, IN_W, NIN);
    prep_w<1><<<dim3(DM / 64, DM / 64, DEPTH), 256, 0, stream>>>(w_out, nullptr, Wout, DM, DM, DM);
    prep_w<2><<<dim3(NUP / 64, DM / 64, DEPTH), 256, 0, stream>>>(w_up, ln2, Wup, DM, NUP, NUP);
    prep_w<1><<<dim3(DM / 64, DFF / 64, DEPTH), 256, 0, stream>>>(w_down, nullptr, Wdown, DFF, DM, DM);
    prep_x<<<M / 4, 256, 0, stream>>>(x, X, XB, ROWSQ);
    for (int l = 0; l < DEPTH; ++l) {
        GArgs g{}; g.rowsq = ROWSQ; g.X = X; g.XB = XB; g.Z = Z; g.gates = GATES; g.b_i = m_b_i + 4 * l; g.b_f = m_b_f + 4 * l; g.hact = HACT; g.fconv = ffn_conv + (size_t)l * 3 * NUP;
        g.A = XB; g.lda = DM; g.Bt = Win + (size_t)l * NIN * DM; g.K = DM;
        gemm_naive<0><<<dim3(M / 64, NIN / 64), 256, 0, stream>>>(g);
        qknorm_naive<<<M * 16 / 4, 256, 0, stream>>>(Z, a_q_g + 64 * l, a_k_g + 64 * l);
        kmean_naive<<<16 * 32, 64, 0, stream>>>(Z, KPART);
        attn_naive<<<M * 8 / 4, 256, 0, stream>>>(Z, KPART, MIX);
        pool_naive<<<M, 256, 0, stream>>>(Z, pool_w + (size_t)l * 4 * 64 * 64, pool_scale + 256 * l, MIX);
        mconv_naive<<<M * 512 / 256, 256, 0, stream>>>(Z, m_conv + (size_t)l * 4 * 512, QKC);
        mlstm_naive<<<8, 256, 0, stream>>>(QKC, Z, GATES, m_norm_g + 256 * l, MIX);
        g.A = MIX; g.lda = DM; g.Bt = Wout + (size_t)l * DM * DM; g.K = DM;
        gemm_naive<1><<<dim3(M / 64, DM / 64), 256, 0, stream>>>(g);
        rowsq_naive<<<M / 4, 256, 0, stream>>>(X, ROWSQ);
        g.A = XB; g.lda = DM; g.Bt = Wup + (size_t)l * NUP * DM; g.K = DM;
        gemm_naive<2><<<dim3(2 * 133, 44), 256, 0, stream>>>(g);
        g.A = HACT; g.lda = DFF; g.Bt = Wdown + (size_t)l * DM * DFF; g.K = DFF;
        gemm_naive<1><<<dim3(M / 64, DM / 64), 256, 0, stream>>>(g);
        rowsq_naive<<<M / 4, 256, 0, stream>>>(X, ROWSQ);
    }
}
```

```cpp
#include <hip/hip_runtime.h>
#include <cstdint>
#include <cstdio>

typedef unsigned short bf16;
typedef unsigned v4u __attribute__((ext_vector_type(4)));
typedef float f32x4 __attribute__((ext_vector_type(4)));

constexpr int BATCH = 2, SEQ = 8192, DM = 1024, DEPTH = 4, M = BATCH * SEQ;
constexpr int IN_W = 2824, NIN = 3072, ZP = 2816, DFF = 2816, NUP = 5632;
constexpr float EPS = 1e-6f;
constexpr float C2 = 0.125f * 1.4426950408889634f;
constexpr int ZC_AQ = 0, ZC_AK = 512, ZC_AV = 1024, ZC_POOL = 1536, ZC_MQ = 1792, ZC_MK = 2048, ZC_MV = 2304, ZC_MO = 2560, ZC_GATE = 2816;
constexpr int MC_POOL = 0, MC_ML = 256, MC_AT = 512;

constexpr size_t MiB = 1u << 20;
constexpr size_t WS_CTL = 0;
constexpr size_t WS_WIN = 1 * MiB;
constexpr size_t WS_WOUT = 25 * MiB;
constexpr size_t WS_WUP = 33 * MiB;
constexpr size_t WS_WDOWN = 77 * MiB;
constexpr size_t WS_XB = 99 * MiB;
constexpr size_t WS_Z = 131 * MiB;
constexpr size_t WS_MIX = 219 * MiB;
constexpr size_t WS_GATES = 251 * MiB;
constexpr size_t WS_ROWSQ = 252 * MiB;
constexpr size_t WS_KPART = 253 * MiB;
constexpr size_t WS_LIST = 254 * MiB;
constexpr size_t WS_DLOC = 270 * MiB;
constexpr size_t WS_CT = 278 * MiB;
constexpr size_t WS_NLOC = 282 * MiB;
constexpr size_t WS_NPREV = 283 * MiB;
constexpr size_t WS_SCAL = 284 * MiB;
constexpr size_t WS_MPREV = 284 * MiB + 65536;
constexpr size_t WS_PWT = 285 * MiB;
constexpr size_t WS_PARTO = 286 * MiB;
constexpr size_t WS_PARTL = 334 * MiB;
constexpr size_t WS_END = 336 * MiB;

__host__ __device__ __forceinline__ unsigned f2bf(float f) { unsigned u = __builtin_bit_cast(unsigned, f); return (u + 0x7fffu + ((u >> 16) & 1u)) >> 16; }
__device__ __forceinline__ float bf2f(unsigned b) { return __builtin_bit_cast(float, (b & 0xffffu) << 16); }
__device__ __forceinline__ unsigned pk2(float lo, float hi) { return f2bf(lo) | (f2bf(hi) << 16); }
__device__ __forceinline__ float sigmoidf_(float x) { return 1.f / (1.f + __expf(-x)); }
__device__ __forceinline__ float siluf_(float x) { return x / (1.f + __expf(-x)); }
__device__ __forceinline__ float wave_sum(float v) {
#pragma unroll
    for (int o = 1; o < 64; o <<= 1) v += __shfl_xor(v, o);
    return v;
}
__device__ __forceinline__ float wave_max(float v) {
#pragma unroll
    for (int o = 1; o < 64; o <<= 1) v = fmaxf(v, __shfl_xor(v, o));
    return v;
}

__host__ __device__ __forceinline__ int in_orig_col(int zc) { return zc < 1536 ? 1288 + zc : (zc < 2816 ? zc - 1536 : (zc < 2824 ? 1280 + (zc - 2816) : -1)); }
__host__ __device__ __forceinline__ int in_row_to_zc(int r) { const int pn = r >> 8, s = r & 255; return 256 * pn + 64 * ((s >> 5) & 3) + 32 * (s >> 7) + (s & 31); }
__host__ __device__ __forceinline__ int up_row_to_orig(int r) { const int pn = r >> 8, s = r & 255; return (s >> 7) * DFF + 128 * pn + (s & 127); }

namespace pg8 {
#define PG8_LAS __attribute__((address_space(3)))
typedef unsigned short bf16_t;
typedef short bf16x8 __attribute__((ext_vector_type(8)));
typedef float f32x4 __attribute__((ext_vector_type(4)));
typedef unsigned u32x4 __attribute__((ext_vector_type(4)));
constexpr int BM = 256, BK = 64, HALF = 128, HTB = HALF * BK * 2  , STAGE_BYTES = 8 * HTB, NXCD = 8, WGM = 8;

__host__ __device__ __forceinline__ int lds_byte(int r, int c) { const int st = (r >> 4) * 2 + (c >> 5), rr = r & 15, cc = c & 31, ob = rr * 64 + cc * 2; return st * 1024 + (ob ^ (((ob >> 9) & 1) << 5)); }
__host__ __device__ __forceinline__ void stage_rc(int b, int& R, int& C) { const int st = b / 1024, sb = b % 1024, swz = sb ^ (((sb >> 9) & 1) << 5); R = (st >> 1) * 16 + swz / 64; C = (st & 1) * 32 + (swz % 64) / 2; }
__host__ __device__ __forceinline__ int perm32(int rho) { const int n = rho >> 4, i = rho & 15; return 8 * (i >> 2) + 4 * n + (i & 3); }

struct Unit { int pm, pn, arow; };
struct Gemm { const bf16_t* A; const bf16_t* Bt; int M, N, K; };

struct StaticOrder {
    int nM, nN, nwg, G, c, nx, pm0;
    __host__ __device__ void init(int nM_, int nN_, int G_, int c_, int nx_, int pm0_) { nM = nM_; nN = nN_; nwg = nM * nN; G = G_; c = c_; nx = nx_; pm0 = pm0_; }
    __host__ __device__ bool next(int i, Unit& u) const {
        const long L = (long)i * G + c; if (L >= nwg) return false;
        int wgid = (int)L; { const int q = nwg / nx, r = nwg % nx, xcd = wgid % nx, off = wgid / nx; wgid = (xcd < r ? xcd * (q + 1) : r * (q + 1) + (xcd - r) * q) + off; }
        const int nig = WGM * nN, gid = wgid / nig, fm = gid * WGM, gsz = (nM - fm) < WGM ? (nM - fm) : WGM;
        u.pm = pm0 + fm + ((wgid % nig) % gsz); u.pn = (wgid % nig) / gsz; u.arow = u.pm * BM; return true;
    }
    __device__ __forceinline__ void a_ready(const Unit&) const {}
    __device__ __forceinline__ void done(const Unit&) const {}
};


template <class Epi, class Sched, bool ALIGN_EPI = false, bool SP2 = false>
__device__ __forceinline__ void gemm_phase(PG8_LAS unsigned char* lds, const Gemm g, const Sched& S, const Epi& E, const int tid) {
    const int wid = __builtin_amdgcn_readfirstlane(tid >> 6), lane = tid & 63, wr = wid >> 2, wc = wid & 3, fr = lane & 15, fq = lane >> 4;
    const int K = g.K, nt = K / BK;
    unsigned voffA[2], voffB[2];
#pragma unroll
    for (int i = 0; i < 2; ++i) { int R, C; stage_rc(tid * 16 + i * 8192, R, C); const int Rb = Epi::PERM ? ((R & ~31) + perm32(R & 31)) : R;
        voffA[i] = (unsigned)(R * K + C) * 2u; voffB[i] = (unsigned)(Rb * K + C) * 2u; }
    const size_t kstep = (size_t)(BK * 2);
    const size_t hstep = (size_t)HALF * K * 2;
    const size_t tstep = 2 * hstep;
    const unsigned ldsw = (unsigned)wid * 1024u;
    const int aoff = lds_byte(wr * 64 + fr, fq * 8), boff = lds_byte(wc * 32 + fr, fq * 8);
#define PG8_SA(b, h) (((b) * 2 + (h)) * HTB)
#define PG8_SB(b, h) ((4 + (b) * 2 + (h)) * HTB)
#define PG8_STAGE(bufoff, gbase, voff) do { _Pragma("unroll") for (int _i = 0; _i < 2; ++_i) \
        __builtin_amdgcn_global_load_lds((const unsigned*)((const char*)(gbase) + (voff)[_i]), (PG8_LAS unsigned*)(lds + (bufoff) + ldsw + _i * 8192), 16, 0, 0); } while (0)
#define PG8_LDA(dst, b, h) do { _Pragma("unroll") for (int m = 0; m < 4; ++m) _Pragma("unroll") for (int k = 0; k < 2; ++k) dst[m][k] = *(const PG8_LAS bf16x8*)(lds + PG8_SA(b, h) + aoff + m * 2048 + k * 1024); } while (0)
#define PG8_LDB(dst, b, h) do { _Pragma("unroll") for (int n = 0; n < 2; ++n) _Pragma("unroll") for (int k = 0; k < 2; ++k) dst[n][k] = *(const PG8_LAS bf16x8*)(lds + PG8_SB(b, h) + boff + n * 2048 + k * 1024); } while (0)
#define PG8_MMA(ai, bj, At, Bt) do { __builtin_amdgcn_s_setprio(1); _Pragma("unroll") for (int m = 0; m < 4; ++m) _Pragma("unroll") for (int n = 0; n < 2; ++n) _Pragma("unroll") for (int k = 0; k < 2; ++k) \
        acc[ai][bj][m][n] = __builtin_amdgcn_mfma_f32_16x16x32_bf16(Bt[n][k], At[m][k], acc[ai][bj][m][n], 0, 0, 0); __builtin_amdgcn_s_setprio(0); } while (0)
#define PG8_WAIT_V(n) asm volatile("s_waitcnt vmcnt(" #n ")" ::: "memory")
#define PG8_WAIT_L(n) asm volatile("s_waitcnt lgkmcnt(" #n ")" ::: "memory")
#define PG8_BAR __builtin_amdgcn_s_barrier()
#define PG8_SCHED __builtin_amdgcn_sched_barrier(0)
    Unit cur, nxt; int ui = 0;
    if (!S.next(0, cur)) return;
    f32x4 acc[2][2][4][2];
#pragma unroll
    for (int a = 0; a < 2; ++a)
#pragma unroll
        for (int b = 0; b < 2; ++b)
#pragma unroll
            for (int m = 0; m < 4; ++m)
#pragma unroll
                for (int n = 0; n < 2; ++n) acc[a][b][m][n] = (f32x4){0.f, 0.f, 0.f, 0.f};
    bf16x8 At[4][2], B0[2][2], B1[2][2];
    const char* cA = (const char*)g.A + (ptrdiff_t)cur.arow * (ptrdiff_t)(K * 2); const char* cB = (const char*)g.Bt + (size_t)cur.pn * tstep;
    S.a_ready(cur);
    if constexpr (SP2) {
        PG8_STAGE(PG8_SB(0, 0), cB, voffB); PG8_STAGE(PG8_SB(0, 1), cB + hstep, voffB); PG8_STAGE(PG8_SA(0, 0), cA, voffA); PG8_STAGE(PG8_SA(0, 1), cA + hstep, voffA);
        if (wr == 1) PG8_BAR;
        PG8_WAIT_V(2); PG8_BAR;
        PG8_STAGE(PG8_SB(1, 0), cB + kstep, voffB); PG8_STAGE(PG8_SA(1, 0), cA + kstep, voffA); PG8_STAGE(PG8_SB(1, 1), cB + hstep + kstep, voffB);
        PG8_WAIT_V(6); PG8_BAR;
    } else {
        PG8_STAGE(PG8_SB(0, 0), cB, voffB); PG8_STAGE(PG8_SA(0, 0), cA, voffA); PG8_STAGE(PG8_SB(0, 1), cB + hstep, voffB); PG8_STAGE(PG8_SA(0, 1), cA + hstep, voffA);
        if (wr == 1) PG8_BAR;
        PG8_WAIT_V(4); PG8_BAR;
        PG8_STAGE(PG8_SB(1, 0), cB + kstep, voffB); PG8_STAGE(PG8_SA(1, 0), cA + kstep, voffA); PG8_STAGE(PG8_SB(1, 1), cB + hstep + kstep, voffB);
        PG8_WAIT_V(6); PG8_BAR;
    }
    for (;;) {
        const bool has_next = S.next(ui + 1, nxt);
        const char* nA = has_next ? (const char*)g.A + (ptrdiff_t)nxt.arow * (ptrdiff_t)(K * 2) : cA; const char* nB = has_next ? (const char*)g.Bt + (size_t)nxt.pn * tstep : cB;
        for (int t = 0; t < nt; t += 2) {
            const bool last = (t == nt - 2);
            const char* a1 = cA + (size_t)(t + 1) * kstep;
            const char* a2 = last ? nA : cA + (size_t)(t + 2) * kstep; const char* b2 = last ? nB : cB + (size_t)(t + 2) * kstep;
            const char* a3 = a2 + kstep; const char* b3 = b2 + kstep;
            if (last && has_next) S.a_ready(nxt);
            if constexpr (SP2) {
            PG8_LDB(B0, 0, 0); PG8_LDB(B1, 0, 1); PG8_SCHED; PG8_LDA(At, 0, 0); PG8_STAGE(PG8_SA(1, 1), a1 + hstep, voffA);
            PG8_WAIT_V(8); PG8_WAIT_L(0); PG8_BAR; PG8_MMA(0, 0, At, B0); PG8_MMA(0, 1, At, B1); PG8_BAR; PG8_SCHED;
            PG8_LDA(At, 0, 1); PG8_STAGE(PG8_SB(0, 0), b2, voffB); PG8_STAGE(PG8_SB(0, 1), b2 + hstep, voffB); PG8_STAGE(PG8_SA(0, 0), a2, voffA);
            PG8_WAIT_V(8); PG8_WAIT_L(0); PG8_BAR; PG8_MMA(1, 0, At, B0); PG8_MMA(1, 1, At, B1); PG8_BAR; PG8_SCHED;
            PG8_LDB(B0, 1, 0); PG8_LDB(B1, 1, 1); PG8_SCHED; PG8_LDA(At, 1, 0); PG8_STAGE(PG8_SA(0, 1), a2 + hstep, voffA);
            PG8_WAIT_V(8); PG8_WAIT_L(0); PG8_BAR; PG8_MMA(0, 0, At, B0); PG8_MMA(0, 1, At, B1); PG8_BAR; PG8_SCHED;
            PG8_LDA(At, 1, 1); PG8_STAGE(PG8_SB(1, 0), b3, voffB); PG8_STAGE(PG8_SB(1, 1), b3 + hstep, voffB); PG8_STAGE(PG8_SA(1, 0), a3, voffA);
            PG8_WAIT_V(8); PG8_WAIT_L(0); PG8_BAR; PG8_MMA(1, 0, At, B0); PG8_MMA(1, 1, At, B1); PG8_BAR; PG8_SCHED;
            } else {
            PG8_LDB(B0, 0, 0); PG8_SCHED; PG8_LDA(At, 0, 0); PG8_STAGE(PG8_SA(1, 1), a1 + hstep, voffA);
            PG8_WAIT_L(8); PG8_BAR; PG8_WAIT_L(0); PG8_MMA(0, 0, At, B0); PG8_BAR; PG8_SCHED;
            PG8_LDB(B1, 0, 1); PG8_STAGE(PG8_SB(0, 0), b2, voffB);
            PG8_BAR; PG8_WAIT_L(0); PG8_MMA(0, 1, At, B1); PG8_BAR;
            PG8_LDA(At, 0, 1); PG8_STAGE(PG8_SA(0, 0), a2, voffA);
            PG8_BAR; PG8_WAIT_L(0); PG8_MMA(1, 0, At, B0); PG8_BAR; PG8_SCHED;
            PG8_STAGE(PG8_SB(0, 1), b2 + hstep, voffB);
            PG8_WAIT_V(6); PG8_BAR; PG8_MMA(1, 1, At, B1); PG8_BAR;
            PG8_LDB(B0, 1, 0); PG8_SCHED; PG8_LDA(At, 1, 0); PG8_STAGE(PG8_SA(0, 1), a2 + hstep, voffA);
            PG8_WAIT_L(8); PG8_BAR; PG8_WAIT_L(0); PG8_MMA(0, 0, At, B0); PG8_BAR; PG8_SCHED;
            PG8_LDB(B1, 1, 1); PG8_STAGE(PG8_SB(1, 0), b3, voffB);
            PG8_BAR; PG8_WAIT_L(0); PG8_MMA(0, 1, At, B1); PG8_BAR;
            PG8_LDA(At, 1, 1); PG8_STAGE(PG8_SA(1, 0), a3, voffA);
            PG8_BAR; PG8_WAIT_L(0); PG8_MMA(1, 0, At, B0); PG8_BAR; PG8_SCHED;
            PG8_STAGE(PG8_SB(1, 1), b3 + hstep, voffB);
            PG8_WAIT_V(6); PG8_BAR; PG8_MMA(1, 1, At, B1); PG8_BAR;
            }
        }
        if constexpr (ALIGN_EPI) { if (wr == 0) PG8_BAR; }
        if constexpr (!Epi::AFTER_DRAIN) { E(acc, cur, wr, wc, fr, fq, lds); S.done(cur); }
        if (!has_next) break;
#pragma unroll
        for (int a = 0; a < 2; ++a)
#pragma unroll
            for (int b = 0; b < 2; ++b)
#pragma unroll
                for (int m = 0; m < 4; ++m)
#pragma unroll
                    for (int n = 0; n < 2; ++n) acc[a][b][m][n] = (f32x4){0.f, 0.f, 0.f, 0.f};
        cur = nxt; cA = nA; cB = nB; ++ui;
        if constexpr (ALIGN_EPI) { if (wr == 1) PG8_BAR; }
    }
    PG8_WAIT_V(0);
    if constexpr (!ALIGN_EPI) { if (wr == 0) PG8_BAR; }
    PG8_BAR;
    if constexpr (Epi::AFTER_DRAIN) { E.fused(acc, cur, wr, wc, fr, fq, lds, wid, lane); S.done(cur); }
#undef PG8_SA
#undef PG8_SB
#undef PG8_STAGE
#undef PG8_LDA
#undef PG8_LDB
#undef PG8_MMA
#undef PG8_WAIT_V
#undef PG8_WAIT_L
#undef PG8_BAR
#undef PG8_SCHED
}
}

namespace pg8 {
typedef float f32x2_t __attribute__((ext_vector_type(2))); typedef __bf16 bf16x2_t __attribute__((ext_vector_type(2)));
__device__ __forceinline__ unsigned cvtpk(float lo, float hi) { f32x2_t v = {lo, hi}; bf16x2_t b = __builtin_convertvector(v, bf16x2_t); return __builtin_bit_cast(unsigned, b); }
__device__ __forceinline__ u32x4 pack8(const f32x4 a, const f32x4 b) { u32x4 w; w.x = cvtpk(a.x, a.y); w.y = cvtpk(a.z, a.w); w.z = cvtpk(b.x, b.y); w.w = cvtpk(b.z, b.w); return w; }
__device__ __forceinline__ float dot4(const f32x4 a) { return (a.x * a.x + a.y * a.y) + (a.z * a.z + a.w * a.w); }
__device__ __forceinline__ float rstd_of(const f32x4 a) { return __builtin_amdgcn_rsqf(((a.x + a.y) + (a.z + a.w)) * (1.f / 1024.f) + 1e-6f); }
__device__ __forceinline__ float fsigmoid(float x) { return __builtin_amdgcn_rcpf(1.f + __builtin_amdgcn_exp2f(-1.4426950408889634f * x)); }
template <int CTRL> __device__ __forceinline__ float dpp_rot(float src) { return __builtin_bit_cast(float, __builtin_amdgcn_update_dpp(__builtin_bit_cast(int, src), __builtin_bit_cast(int, src), CTRL, 0xf, 0xf, true)); }
template <int CTRL> __device__ __forceinline__ float dpp_mov(float old, float src) { return __builtin_bit_cast(float, __builtin_amdgcn_update_dpp(__builtin_bit_cast(int, old), __builtin_bit_cast(int, src), CTRL, 0xf, 0xf, false)); }

struct EpiIn {
    static constexpr bool PERM = true, AFTER_DRAIN = false;
    bf16_t* Z; float* gates; float* kpart; const float* rowsq; const float* gq; const float* gk; const float* b_i; const float* b_f;
    __device__ __forceinline__ void operator()(f32x4 (&acc)[2][2][4][2], const Unit& u, int wr, int wc, int fr, int fq, PG8_LAS unsigned char*) const {
        const int row0 = u.pm * BM + wr * 64 + fr, pn = u.pn;
        float rs[2][4];
        { f32x4 q[2][4];
#pragma unroll
          for (int ai = 0; ai < 2; ++ai)
#pragma unroll
              for (int m = 0; m < 4; ++m) q[ai][m] = *(const f32x4*)(rowsq + 4 * (size_t)(row0 + ai * HALF + m * 16));
#pragma unroll
          for (int ai = 0; ai < 2; ++ai)
#pragma unroll
              for (int m = 0; m < 4; ++m) rs[ai][m] = rstd_of(q[ai][m]); }
        const int zc0 = 256 * pn + 64 * wc + 8 * fq;
        if (pn < 4) {
            const float* gg = pn < 2 ? gq : gk; const float mul = pn < 2 ? C2 : 1.f;
            f32x4 gv[2][2], ks[2][2];
#pragma unroll
            for (int bj = 0; bj < 2; ++bj)
#pragma unroll
                for (int n = 0; n < 2; ++n) { gv[bj][n] = *(const f32x4*)(gg + 32 * bj + 8 * fq + 4 * n) * mul; ks[bj][n] = (f32x4){0.f, 0.f, 0.f, 0.f}; }
#pragma unroll
            for (int ai = 0; ai < 2; ++ai)
#pragma unroll
                for (int m = 0; m < 4; ++m) {
                    f32x4 v[2][2]; float ss = 0.f;
#pragma unroll
                    for (int bj = 0; bj < 2; ++bj)
#pragma unroll
                        for (int n = 0; n < 2; ++n) { v[bj][n] = acc[ai][bj][m][n] * rs[ai][m]; ss += dot4(v[bj][n]); }
                    ss += __shfl_xor(ss, 16); ss += __shfl_xor(ss, 32);
                    const float r = rsqrtf(ss * (1.f / 64.f) + 1e-6f);
                    bf16_t* rowp = Z + (size_t)(row0 + ai * HALF + m * 16) * ZP + zc0;
#pragma unroll
                    for (int bj = 0; bj < 2; ++bj) { const f32x4 o0 = v[bj][0] * r * gv[bj][0], o1 = v[bj][1] * r * gv[bj][1]; ks[bj][0] += o0; ks[bj][1] += o1; *(u32x4*)(rowp + 32 * bj) = pack8(o0, o1); }
                }
            if (pn >= 2) {
#pragma unroll
                for (int bj = 0; bj < 2; ++bj)
#pragma unroll
                    for (int n = 0; n < 2; ++n)
#pragma unroll
                        for (int e = 0; e < 4; ++e) { float s = ks[bj][n][e]; s += __shfl_xor(s, 1); s += __shfl_xor(s, 2); s += __shfl_xor(s, 4); s += __shfl_xor(s, 8); ks[bj][n][e] = s; }
                if (fr == 0) { const int bh = (u.pm >> 5) * 8 + (pn - 2) * 4 + wc, nb = u.pm & 31; float* kp = kpart + ((size_t)(bh * 32 + nb) * 2 + wr) * 64 + 8 * fq;
#pragma unroll
                    for (int bj = 0; bj < 2; ++bj)
#pragma unroll
                        for (int n = 0; n < 2; ++n) *(f32x4*)(kp + 32 * bj + 4 * n) = ks[bj][n]; }
            }
        } else if (pn < 11) {
#pragma unroll
            for (int ai = 0; ai < 2; ++ai)
#pragma unroll
                for (int m = 0; m < 4; ++m) { bf16_t* rowp = Z + (size_t)(row0 + ai * HALF + m * 16) * ZP + zc0;
#pragma unroll
                    for (int bj = 0; bj < 2; ++bj) { f32x4 v0 = acc[ai][bj][m][0] * rs[ai][m], v1 = acc[ai][bj][m][1] * rs[ai][m];
                        if (pn == 10) {
#pragma unroll
                            for (int e = 0; e < 4; ++e) { v0[e] = fsigmoid(v0[e]); v1[e] = fsigmoid(v1[e]); } }
                        *(u32x4*)(rowp + 32 * bj) = pack8(v0, v1); } }
        } else if (wc == 0 && fq == 0) {
            const f32x4 bi = *(const f32x4*)b_i, bf = *(const f32x4*)b_f;
#pragma unroll
            for (int ai = 0; ai < 2; ++ai)
#pragma unroll
                for (int m = 0; m < 4; ++m) { float* gp = gates + (size_t)(row0 + ai * HALF + m * 16) * 8;
                    *(f32x4*)gp = acc[ai][0][m][0] * rs[ai][m] + bi; *(f32x4*)(gp + 4) = acc[ai][0][m][1] * rs[ai][m] + bf; }
        }
    }
};
constexpr int EXCH_OFF = 131072 + 1024;
struct EpiRes {
    static constexpr bool PERM = true, AFTER_DRAIN = false;
    bf16_t* XB; float* rowsq; float* out;
    __device__ __forceinline__ void operator()(f32x4 (&acc)[2][2][4][2], const Unit& u, int wr, int wc, int fr, int fq, PG8_LAS unsigned char* lds) const {
        const int row0 = u.pm * BM + wr * 64 + fr, col0 = u.pn * BM + wc * 32 + 8 * fq;
        PG8_LAS float* rq = (PG8_LAS float*)(lds + EXCH_OFF);
#pragma unroll
        for (int ai = 0; ai < 2; ++ai) {
            u32x4 xv[4][2];
#pragma unroll
            for (int m = 0; m < 4; ++m)
#pragma unroll
                for (int bj = 0; bj < 2; ++bj) xv[m][bj] = *(const u32x4*)(XB + (size_t)(row0 + ai * HALF + m * 16) * DM + col0 + bj * HALF);
#pragma unroll
            for (int m = 0; m < 4; ++m) { const size_t row = row0 + ai * HALF + m * 16; float ss = 0.f;
#pragma unroll
                for (int bj = 0; bj < 2; ++bj) { const u32x4 w = xv[m][bj];
                    f32x4 x0 = (f32x4){__builtin_bit_cast(float, w.x << 16), __builtin_bit_cast(float, w.x & 0xffff0000u), __builtin_bit_cast(float, w.y << 16), __builtin_bit_cast(float, w.y & 0xffff0000u)};
                    f32x4 x1 = (f32x4){__builtin_bit_cast(float, w.z << 16), __builtin_bit_cast(float, w.z & 0xffff0000u), __builtin_bit_cast(float, w.w << 16), __builtin_bit_cast(float, w.w & 0xffff0000u)};
                    x0 += acc[ai][bj][m][0]; x1 += acc[ai][bj][m][1];
                    ss += dot4(x0) + dot4(x1); *(u32x4*)(XB + row * DM + col0 + bj * HALF) = pack8(x0, x1);
                    }
                ss += __shfl_xor(ss, 16); ss += __shfl_xor(ss, 32);
                if (fq == 0) rq[wc * 256 + ai * HALF + wr * 64 + m * 16 + fr] = ss; }
            asm volatile("" ::: "memory"); }
        asm volatile("s_waitcnt lgkmcnt(0)" ::: "memory"); __builtin_amdgcn_s_barrier(); asm volatile("" ::: "memory");
        { const int r = (wr * 4 + wc) * 64 + fq * 16 + fr; if (r < 256) rowsq[(size_t)(u.pm * BM + r) * 4 + u.pn] = (rq[r] + rq[256 + r]) + (rq[512 + r] + rq[768 + r]); }
    }
};
struct EpiUp {
    static constexpr bool PERM = true, AFTER_DRAIN = false;
    bf16_t* hact; const float* rowsq; const float* fconv; bf16_t* trash;
    __device__ __forceinline__ void operator()(f32x4 (&acc)[2][2][4][2], const Unit& u, int wr, int wc, int fr, int fq, PG8_LAS unsigned char* lds) const {
        const int b = u.pm / 33, tb = u.pm - 33 * b, t0 = 254 * tb - 2, rbase = wr * 64 + fr;
#pragma unroll
        for (int ai = 0; ai < 2; ++ai) { f32x4 q[4];
#pragma unroll
            for (int m = 0; m < 4; ++m) { const int t = t0 + ai * HALF + m * 16 + rbase; const int tc = t < 0 ? 0 : (t >= SEQ ? SEQ - 1 : t); q[m] = *(const f32x4*)(rowsq + 4 * ((size_t)b * SEQ + tc)); }
#pragma unroll
            for (int m = 0; m < 4; ++m) { const int t = t0 + ai * HALF + m * 16 + rbase; const float rs = (t >= 0 && t < SEQ) ? rstd_of(q[m]) : 0.f;
#pragma unroll
                for (int bj = 0; bj < 2; ++bj)
#pragma unroll
                    for (int n = 0; n < 2; ++n)
#pragma unroll
                        for (int e = 0; e < 4; ++e) acc[ai][bj][m][n][e] *= rs; } }
        PG8_LAS float* ex = (PG8_LAS float*)(lds + EXCH_OFF);
        if (fr >= 14) {
#pragma unroll
            for (int ai = 0; ai < 2; ++ai)
#pragma unroll
                for (int bj = 0; bj < 2; ++bj)
#pragma unroll
                    for (int n = 0; n < 2; ++n) *(PG8_LAS f32x4*)(ex + ((((ai * 2 + wr) * 4 + wc) * 2 + (fr - 14)) * 64 + 32 * bj + 8 * fq + 4 * n)) = acc[ai][bj][3][n]; }
        PG8_LAS float* wl = ex + 2048;
        { const int wt = ((wr * 4 + wc) * 4 + fq) * 16 + fr; if (wt < 192) { const int j = wt >> 6, bj = (wt >> 5) & 1, c4 = (wt & 31) * 4; *(PG8_LAS f32x4*)(wl + (j * 2 + bj) * 128 + c4) = *(const f32x4*)(fconv + j * NUP + bj * DFF + 128 * u.pn + c4); } }
        asm volatile("s_waitcnt vmcnt(0) lgkmcnt(0)" ::: "memory"); __builtin_amdgcn_s_barrier(); asm volatile("" ::: "memory");
        const int ch0 = 128 * u.pn + 32 * wc + 8 * fq;
#pragma unroll
        for (int ai = 0; ai < 2; ++ai) {
            const bool has_prev = !(ai == 0 && wr == 0); const int sai = wr ? ai : 0, swr = wr ? 0 : 1;
#pragma unroll
            for (int mm = 0; mm < 4; ++mm) { const int m = 3 - mm;
#pragma unroll
                for (int bj = 0; bj < 2; ++bj)
#pragma unroll
                    for (int n = 0; n < 2; ++n) {
                        const f32x4 cur = acc[ai][bj][m][n]; f32x4 c1, c2;
                        if (m > 0) { const f32x4 pv = acc[ai][bj][m - 1][n];
#pragma unroll
                            for (int e = 0; e < 4; ++e) { const float r1 = dpp_rot<0x121>(pv[e]), r2 = dpp_rot<0x122>(pv[e]); c1[e] = dpp_mov<0x111>(r1, cur[e]); c2[e] = dpp_mov<0x112>(r2, cur[e]); }
                        } else { f32x4 p14 = (f32x4){0.f, 0.f, 0.f, 0.f}, p15 = p14;
                            if (has_prev) { const PG8_LAS float* sp = ex + ((((sai * 2 + swr) * 4 + wc) * 2) * 64 + 32 * bj + 8 * fq + 4 * n); p14 = *(const PG8_LAS f32x4*)sp; p15 = *(const PG8_LAS f32x4*)(sp + 64); }
#pragma unroll
                            for (int e = 0; e < 4; ++e) { const float r1 = p15[e], r2 = fr == 0 ? p14[e] : p15[e]; c1[e] = dpp_mov<0x111>(r1, cur[e]); c2[e] = dpp_mov<0x112>(r2, cur[e]); } }
                        const PG8_LAS float* wp = wl + bj * 128 + 32 * wc + 8 * fq + 4 * n;
                        acc[ai][bj][m][n] = *(const PG8_LAS f32x4*)(wp + 512) * cur + *(const PG8_LAS f32x4*)(wp + 256) * c1 + *(const PG8_LAS f32x4*)wp * c2;
                    }
                const int r = ai * HALF + m * 16 + rbase, t = t0 + r;
                { f32x4 h0, h1;
#pragma unroll
                    for (int e = 0; e < 4; ++e) { const float g0 = acc[ai][0][m][0][e], g1 = acc[ai][0][m][1][e]; h0[e] = g0 * fsigmoid(g0) * acc[ai][1][m][0][e]; h1[e] = g1 * fsigmoid(g1) * acc[ai][1][m][1][e]; }
                    if (r >= 2 && t < SEQ) *(u32x4*)(hact + ((size_t)b * SEQ + t) * DFF + ch0) = pack8(h0, h1); }
            }
        }
    }
};
struct UpOrder : StaticOrder {
    __device__ bool next(int i, Unit& u) const { if (!StaticOrder::next(i, u)) return false; const int b = u.pm / 33, tb = u.pm - 33 * b; u.arow = b * SEQ + 254 * tb - 2; return true; }
};
}

#define GAS __attribute__((address_space(1)))
#define LAS __attribute__((address_space(3)))
typedef unsigned short bf16;
typedef unsigned v4u __attribute__((ext_vector_type(4)));
typedef float f32x4 __attribute__((ext_vector_type(4)));
typedef short bf16x8 __attribute__((ext_vector_type(8)));
typedef GAS unsigned gu32;
typedef GAS unsigned long long gu64;
#define RLX_AGENT __ATOMIC_RELAXED, __HIP_MEMORY_SCOPE_AGENT
#define LDS_WAIT() asm volatile("s_waitcnt lgkmcnt(0)" ::: "memory")
#define VM_WAIT() asm volatile("s_waitcnt vmcnt(0)" ::: "memory")
__device__ __forceinline__ unsigned long long rt() { return __builtin_amdgcn_s_memrealtime(); }

#define XB_TMO      128
#define XB_XCNT(j)  (256  + 64 * (j))
#define XB_XSUB(j)  (1280 + 64 * (j))
#define XB_XGEN(j)  (2304 + 64 * (j))
#define XB_TOP      3328
#define XB_TOPGEN   3392
#define XCD_BAR_WORDS 3456
#define XB_SPIN_CAP (1u << 18)

__device__ __forceinline__ unsigned xb_ld(unsigned* p)              { return __hip_atomic_load(p, __ATOMIC_RELAXED, __HIP_MEMORY_SCOPE_AGENT); }
__device__ __forceinline__ unsigned xb_add(unsigned* p, unsigned v) { return __hip_atomic_fetch_add(p, v, __ATOMIC_RELAXED, __HIP_MEMORY_SCOPE_AGENT); }
__device__ __forceinline__ unsigned xb_xcc_id() { return (unsigned)__builtin_amdgcn_s_getreg((3 << 11) | 20) & 0xFu; }
#define XB_SPIN(cond, bar) do { unsigned _sp = 0; while (cond) { __builtin_amdgcn_s_sleep(1); \
    if ((++_sp & 255u) == 0u) { if (xb_ld(&(bar)[XB_TMO])) break; if (_sp > XB_SPIN_CAP) { atomicAdd(&(bar)[XB_TMO], 1u); break; } } } } while (0)

struct XcdBarrier {
    unsigned* bar; unsigned x; unsigned G;
    volatile LAS unsigned* st;
};

__device__ __forceinline__ XcdBarrier xcd_barrier_post(unsigned* bar, volatile LAS unsigned* st, unsigned G) {
    XcdBarrier b; b.bar = bar; b.x = xb_xcc_id(); b.st = st; b.G = G;
    if (threadIdx.x == 0) (void)xb_add(&bar[XB_XCNT(b.x)], 1u);
    return b;
}
__device__ __forceinline__ void xcd_barrier_complete(unsigned* bar, unsigned x, unsigned G, unsigned& nloc, unsigned& nx) {
    unsigned sum, cnt, mine, sp = 0u;
    for (;;) {
        sum = 0u; cnt = 0u; mine = 0u;
#pragma unroll
        for (unsigned j = 0; j < 16; ++j) { const unsigned c = xb_ld(&bar[XB_XCNT(j)]); sum += c; cnt += (c > 0u) ? 1u : 0u; mine = (j == x) ? c : mine; }
        if (sum == G) break;
        __builtin_amdgcn_s_sleep(1);
        if ((++sp & 255u) == 0u) { if (xb_ld(&bar[XB_TMO])) break; if (sp > XB_SPIN_CAP) { atomicAdd(&bar[XB_TMO], 1u); break; } }
    }
    nloc = mine > 0u ? mine : 1u; nx = cnt > 0u ? cnt : 1u;
}

__device__ __forceinline__ void xcd_barrier(const XcdBarrier& b) {
    asm volatile("s_waitcnt vmcnt(0)" ::: "memory");
    __syncthreads();
    if (threadIdx.x == 0) {
        unsigned* bar = b.bar;
        __builtin_amdgcn_s_waitcnt(0);
        unsigned nloc = b.st[0], nx = b.st[1];
        if (nloc == 0u) { xcd_barrier_complete(bar, b.x, b.G, nloc, nx); b.st[0] = nloc; b.st[1] = nx; }
        const unsigned old = xb_add(&bar[XB_XSUB(b.x)], 1u);
        const unsigned gen = old / nloc;
        if (old + 1u == (gen + 1u) * nloc) {
            __builtin_amdgcn_fence(__ATOMIC_RELEASE, "agent");
            asm volatile("s_waitcnt vmcnt(0)" ::: "memory");
            const unsigned og = xb_add(&bar[XB_TOP], 1u);
            const unsigned tg = og / nx;
            if (og + 1u == (tg + 1u) * nx) xb_add(&bar[XB_TOPGEN], 1u);
            else XB_SPIN(xb_ld(&bar[XB_TOPGEN]) == tg, bar);
            __builtin_amdgcn_fence(__ATOMIC_ACQUIRE, "agent");
            xb_add(&bar[XB_XGEN(b.x)], 1u);
            asm volatile("s_waitcnt vmcnt(0)" ::: "memory");
        } else {
            XB_SPIN(xb_ld(&bar[XB_XGEN(b.x)]) == gen, bar);
            __builtin_amdgcn_fence(__ATOMIC_ACQUIRE, "agent");
            asm volatile("s_waitcnt vmcnt(0)" ::: "memory");
        }
    }
    __syncthreads();
}

namespace moba {
using bf16x8 = __attribute__((ext_vector_type(8))) short;
using s16x4 = __attribute__((ext_vector_type(4))) short;
using f32x16 = __attribute__((ext_vector_type(16))) float;
using u32x4 = __attribute__((ext_vector_type(4))) unsigned;
typedef short v4i16_t __attribute__((ext_vector_type(4)));
constexpr int NW = 8, QBLK = 32, QB = 256, KVBLK = 64;
constexpr int NSLOT = 3, SLOTB = 8192;
constexpr int LDS_K = 0, LDS_V = NSLOT * SLOTB, LDS_WS = 2 * NSLOT * SLOTB, LDS_OST = LDS_WS + NW * 64 * 4, LDS_TOTAL = LDS_OST + NW * 4096;
__device__ __forceinline__ int crow(int r, int hi) { return (r & 3) + 8 * (r >> 2) + 4 * hi; }
#define MB_SBAR() __builtin_amdgcn_sched_barrier(0)
__device__ __forceinline__ void glds16(const void* gsrc, unsigned lds_dst) { unsigned keep;
    asm volatile("s_mov_b32 %0, m0\n\ts_mov_b32 m0, %2\n\ts_nop 0\n\tglobal_load_lds_dwordx4 %1, off\n\ts_mov_b32 m0, %0" : "=&s"(keep) : "v"(gsrc), "s"(lds_dst) : "memory"); }
typedef float f32x2_t __attribute__((ext_vector_type(2))); typedef __bf16 bf16x2_t __attribute__((ext_vector_type(2)));
__device__ __forceinline__ unsigned cvtpk_s(float lo, float hi) { f32x2_t v = {lo, hi}; bf16x2_t b = __builtin_convertvector(v, bf16x2_t); return __builtin_bit_cast(unsigned, b); }
#define MB_WAIT_BAR(N) asm volatile("s_waitcnt vmcnt(" #N ") lgkmcnt(0)\n\ts_barrier" ::: "memory")
typedef __attribute__((address_space(3))) const char* lds_cptr;

__device__ __forceinline__ void qkt(f32x16& p0, f32x16& p1, lds_cptr Kslot, const bf16x8* qr, const f32x16& cin, int r32, int hi) {
    lds_cptr kb = Kslot + hi * 1024 + r32 * 16;
#pragma unroll
    for (int d0 = 0; d0 < 4; ++d0) {
        const bf16x8 b0 = *(const __attribute__((address_space(3))) bf16x8*)(kb + d0 * 2048);
        const bf16x8 b1 = *(const __attribute__((address_space(3))) bf16x8*)(kb + d0 * 2048 + 512);
        if (d0 == 0) { p0 = __builtin_amdgcn_mfma_f32_32x32x16_bf16(b0, qr[0], cin, 0, 0, 0); p1 = __builtin_amdgcn_mfma_f32_32x32x16_bf16(b1, qr[0], cin, 0, 0, 0); }
        else { p0 = __builtin_amdgcn_mfma_f32_32x32x16_bf16(b0, qr[d0], p0, 0, 0, 0); p1 = __builtin_amdgcn_mfma_f32_32x32x16_bf16(b1, qr[d0], p1, 0, 0, 0); } }
}
__device__ __forceinline__ void pv(f32x16* o, int vb, bf16x8 pa0, bf16x8 pa1, bf16x8 pa2, bf16x8 pa3) {
#pragma unroll
    for (int d0 = 0; d0 < 2; ++d0) { s16x4 lo[4], hi[4];
#pragma unroll
        for (int ks = 0; ks < 4; ++ks) {
            asm volatile("ds_read_b64_tr_b16 %0,%1 offset:%c2" : "=&v"(lo[ks]) : "v"(vb), "i"(d0 * 4096 + ks * 1024) : "memory");
            asm volatile("ds_read_b64_tr_b16 %0,%1 offset:%c2" : "=&v"(hi[ks]) : "v"(vb), "i"(d0 * 4096 + ks * 1024 + 512) : "memory"); }
        asm volatile("s_waitcnt lgkmcnt(0)" ::: "memory"); MB_SBAR();
#define MB_PK(k) (bf16x8){lo[k][0], lo[k][1], lo[k][2], lo[k][3], hi[k][0], hi[k][1], hi[k][2], hi[k][3]}
        o[d0] = __builtin_amdgcn_mfma_f32_32x32x16_bf16(pa0, MB_PK(0), o[d0], 0, 0, 0);
        o[d0] = __builtin_amdgcn_mfma_f32_32x32x16_bf16(pa1, MB_PK(1), o[d0], 0, 0, 0);
        o[d0] = __builtin_amdgcn_mfma_f32_32x32x16_bf16(pa2, MB_PK(2), o[d0], 0, 0, 0);
        o[d0] = __builtin_amdgcn_mfma_f32_32x32x16_bf16(pa3, MB_PK(3), o[d0], 0, 0, 0);
#undef MB_PK
    }
}
__device__ __forceinline__ void pv_read(int vb, s16x4 (&lo)[8], s16x4 (&hi)[8]) {
#pragma unroll
    for (int d0 = 0; d0 < 2; ++d0)
#pragma unroll
        for (int ks = 0; ks < 4; ++ks) {
            asm volatile("ds_read_b64_tr_b16 %0,%1 offset:%c2" : "=&v"(lo[d0 * 4 + ks]) : "v"(vb), "i"(d0 * 4096 + ks * 1024) : "memory");
            asm volatile("ds_read_b64_tr_b16 %0,%1 offset:%c2" : "=&v"(hi[d0 * 4 + ks]) : "v"(vb), "i"(d0 * 4096 + ks * 1024 + 512) : "memory"); }
}
__device__ __forceinline__ void pv_mma(f32x16* o, bf16x8 pa0, bf16x8 pa1, bf16x8 pa2, bf16x8 pa3, s16x4 (&lo)[8], s16x4 (&hi)[8]) {
    asm volatile("s_waitcnt lgkmcnt(0)" : "+v"(lo[0]), "+v"(lo[1]), "+v"(lo[2]), "+v"(lo[3]), "+v"(lo[4]), "+v"(lo[5]), "+v"(lo[6]), "+v"(lo[7]), "+v"(hi[0]), "+v"(hi[1]), "+v"(hi[2]), "+v"(hi[3]), "+v"(hi[4]), "+v"(hi[5]), "+v"(hi[6]), "+v"(hi[7]) :: "memory"); MB_SBAR();
#define MB_PK2(k) (bf16x8){lo[k][0], lo[k][1], lo[k][2], lo[k][3], hi[k][0], hi[k][1], hi[k][2], hi[k][3]}
#pragma unroll
    for (int d0 = 0; d0 < 2; ++d0) {
        o[d0] = __builtin_amdgcn_mfma_f32_32x32x16_bf16(pa0, MB_PK2(d0 * 4 + 0), o[d0], 0, 0, 0);
        o[d0] = __builtin_amdgcn_mfma_f32_32x32x16_bf16(pa1, MB_PK2(d0 * 4 + 1), o[d0], 0, 0, 0);
        o[d0] = __builtin_amdgcn_mfma_f32_32x32x16_bf16(pa2, MB_PK2(d0 * 4 + 2), o[d0], 0, 0, 0);
        o[d0] = __builtin_amdgcn_mfma_f32_32x32x16_bf16(pa3, MB_PK2(d0 * 4 + 3), o[d0], 0, 0, 0); }
#undef MB_PK2
}
__device__ __forceinline__ unsigned bfhi(float x) { const unsigned u = __builtin_bit_cast(unsigned, x); return (u + 0x7fffu + ((u >> 16) & 1u)) >> 16; }

__device__ __forceinline__ void attn_unit(int b, int h, int qb, const bf16* __restrict__ Z, const float* __restrict__ kpart, bf16* __restrict__ mix, LAS unsigned char* shm, const int tid) {
    const int lane = tid & 63, r32 = lane & 31, hi = lane >> 5; const int wid = __builtin_amdgcn_readfirstlane(tid >> 6);
    const long rowbase = (long)b * SEQ; const int q0 = qb * QB;
    const bf16* Qw = Z + (rowbase + q0 + wid * QBLK) * ZP + ZC_AQ + h * 64;
    const bf16* Kh = Z + rowbase * ZP + ZC_AK + h * 64; const bf16* Vh = Z + rowbase * ZP + ZC_AV + h * 64;
    const unsigned lds0 = (unsigned)(uintptr_t)shm;
    LAS float* wsf = (LAS float*)(shm + LDS_WS) + wid * 64;
    const bf16* ksrc = Kh + (long)lane * ZP + wid * 8;
    const bf16* vsrc = Vh + (long)(16 * (wid & 3) + (lane >> 2)) * ZP + (wid >> 2) * 32 + (lane & 3) * 8;
    const unsigned kdst = lds0 + LDS_K + wid * 1024, vdst = lds0 + LDS_V + wid * 1024;
#define MB_DMA_K(t, slot) glds16(ksrc + (long)(t) * KVBLK * ZP, (unsigned)__builtin_amdgcn_readfirstlane(kdst + (slot)))
#define MB_DMA_V(t, slot) glds16(vsrc + (long)(t) * KVBLK * ZP, (unsigned)__builtin_amdgcn_readfirstlane(vdst + (slot)))
    const int vb0 = (int)(lds0 + LDS_V) + ((lane >> 4) & 1) * 32 + (lane & 3) * 8 + (4 * hi + ((lane & 15) >> 2)) * 64;
    const lds_cptr kp0 = (lds_cptr)shm + LDS_K;
    const int NT = 4 * (qb + 1);
    MB_DMA_K(0, 0); MB_DMA_V(0, 0); MB_DMA_K(1, SLOTB); MB_DMA_V(1, SLOTB);
    bf16x8 qr[4];
#pragma unroll
    for (int d0 = 0; d0 < 4; ++d0) qr[d0] = *reinterpret_cast<const bf16x8*>(&Qw[(long)r32 * ZP + d0 * 16 + hi * 8]);
    unsigned selmask = 0u;
    if (qb > 0) {
        f32x16 g = f32x16{};
        const float* kp = kpart + ((size_t)((b * 8 + h) * 32 + r32) * 2) * 64 + hi * 8;
#pragma unroll
        for (int d0 = 0; d0 < 4; ++d0) {
            const f32x4 a0 = *(const f32x4*)(kp + d0 * 16) + *(const f32x4*)(kp + 64 + d0 * 16), a1 = *(const f32x4*)(kp + d0 * 16 + 4) + *(const f32x4*)(kp + 64 + d0 * 16 + 4);
            float v[8] = {a0.x, a0.y, a0.z, a0.w, a1.x, a1.y, a1.z, a1.w}; bf16x8 kh, kl;
#pragma unroll
            for (int j = 0; j < 8; ++j) { const unsigned hb = bfhi(v[j]); kh[j] = (short)hb; kl[j] = (short)bfhi(v[j] - __builtin_bit_cast(float, hb << 16)); }
            g = __builtin_amdgcn_mfma_f32_32x32x16_bf16(kh, qr[d0], g, 0, 0, 0); g = __builtin_amdgcn_mfma_f32_32x32x16_bf16(kl, qr[d0], g, 0, 0, 0); }
#pragma unroll
        for (int r = 0; r < 16; ++r) if (crow(r, hi) >= qb) g[r] = -INFINITY;
#pragma unroll
        for (int k = 0; k < 3; ++k) { float bv = -INFINITY; int bi = 0;
#pragma unroll
            for (int r = 0; r < 16; ++r) if (g[r] > bv) { bv = g[r]; bi = crow(r, hi); }
            const float pvv = __shfl_xor(bv, 32); const int pi = __shfl_xor(bi, 32);
            const bool tp = (pvv > bv) || (pvv == bv && pi < bi); const float best = tp ? pvv : bv; const int besti = tp ? pi : bi;
            if (best > -INFINITY) { selmask |= 1u << besti;
#pragma unroll
                for (int r = 0; r < 16; ++r) if (crow(r, hi) == besti) g[r] = -INFINITY; } }
    }
    float l_reg = 0.f; f32x16 o[2]; o[0] = f32x16{}; o[1] = f32x16{};
    const int qrel = wid * QBLK + r32;
    int slot = 0;
    for (int t = 0; t < NT; ++t) {
        if (t + 1 < NT) MB_WAIT_BAR(2); else MB_WAIT_BAR(0);
        if (t + 2 < NT) { const int s2 = slot >= SLOTB ? slot - SLOTB : slot + 2 * SLOTB; MB_DMA_K(t + 2, s2); MB_DMA_V(t + 2, s2); }
        const int nblk = t >> 2; const bool own = nblk == qb; const bool sel = own || ((selmask >> nblk) & 1u);
        if (__any(sel)) {
            f32x16 cin; const float cv = sel ? 0.f : -1e30f;
#pragma unroll
            for (int r = 0; r < 16; ++r) cin[r] = cv;
            f32x16 p0, p1;
            qkt(p0, p1, kp0 + slot, qr, cin, r32, hi);
            if (own) { const int kb = 64 * (t & 3) + 4 * hi;
#pragma unroll
                for (int r = 0; r < 16; ++r) { const int kv = kb + (r & 3) + 8 * (r >> 2); if (kv > qrel) p0[r] = -1e30f; if (kv + 32 > qrel) p1[r] = -1e30f; } }
            float sacc = 0.f;
#pragma unroll
            for (int r = 0; r < 16; ++r) { p0[r] = __builtin_amdgcn_exp2f(p0[r]); p1[r] = __builtin_amdgcn_exp2f(p1[r]); sacc += p0[r] + p1[r]; }
            l_reg += sacc;
            u32x4 pw0, pw1, pw2, pw3;
            pw0 = (u32x4){cvtpk_s(p0[0], p0[1]), cvtpk_s(p0[2], p0[3]), cvtpk_s(p0[4], p0[5]), cvtpk_s(p0[6], p0[7])};
            pw1 = (u32x4){cvtpk_s(p0[8], p0[9]), cvtpk_s(p0[10], p0[11]), cvtpk_s(p0[12], p0[13]), cvtpk_s(p0[14], p0[15])};
            pw2 = (u32x4){cvtpk_s(p1[0], p1[1]), cvtpk_s(p1[2], p1[3]), cvtpk_s(p1[4], p1[5]), cvtpk_s(p1[6], p1[7])};
            pw3 = (u32x4){cvtpk_s(p1[8], p1[9]), cvtpk_s(p1[10], p1[11]), cvtpk_s(p1[12], p1[13]), cvtpk_s(p1[14], p1[15])};
            MB_SBAR();
            pv(o, vb0 + slot, __builtin_bit_cast(bf16x8, pw0), __builtin_bit_cast(bf16x8, pw1), __builtin_bit_cast(bf16x8, pw2), __builtin_bit_cast(bf16x8, pw3));
        }
        slot = slot == (NSLOT - 1) * SLOTB ? 0 : slot + SLOTB;
    }
    { auto rr = __builtin_amdgcn_permlane32_swap(__float_as_uint(l_reg), __float_as_uint(l_reg), false, false); l_reg = __uint_as_float(rr[0]) + __uint_as_float(rr[1]); }
    if (hi == 0) wsf[32 + r32] = l_reg; asm volatile("s_waitcnt lgkmcnt(0)" ::: "memory");
    float rli[16];
#pragma unroll
    for (int r = 0; r < 16; ++r) rli[r] = __builtin_amdgcn_rcpf(wsf[32 + crow(r, hi)]);
    bf16* Ow = mix + (rowbase + q0 + wid * QBLK) * DM + MC_AT + h * 64;
    { LAS bf16* stg = (LAS bf16*)(shm + LDS_OST) + wid * 2048;
#pragma unroll
      for (int r = 0; r < 16; ++r) { const int orow = crow(r, hi);
#pragma unroll
          for (int d0 = 0; d0 < 2; ++d0) stg[orow * 64 + d0 * 32 + r32] = (bf16)bfhi(o[d0][r] * rli[r]); }
      asm volatile("s_waitcnt lgkmcnt(0)" ::: "memory");
#pragma unroll
      for (int i = 0; i < 4; ++i) { const int row = i * 8 + (lane >> 3), ch = lane & 7; const u32x4 v = *(const LAS u32x4*)(stg + row * 64 + ch * 8); *(u32x4*)(Ow + (long)row * DM + ch * 8) = v; } }
    asm volatile("s_waitcnt lgkmcnt(0)\n\ts_barrier" ::: "memory");
#undef MB_DMA_K
#undef MB_DMA_V
}
constexpr int LCAP = 8192;
constexpr int LDS_OST32 = LDS_WS + NW * 64 * 4, LDS_TOTAL32 = LDS_OST32 + NW * 8192;
struct SelIn { bf16x8 qr[4]; };
constexpr int SKP = 72;
struct SelOut { int n0, n1, n2, r0, r1, r2, nj; unsigned base; };
__device__ __forceinline__ void sel_load(SelIn& in, int b, int h, int qb, const bf16* __restrict__ Z, int wid, int r32, int hi) {
    const bf16* Qw = Z + ((long)b * SEQ + qb * QB + wid * QBLK) * ZP + ZC_AQ + h * 64;
#pragma unroll
    for (int d0 = 0; d0 < 4; ++d0) in.qr[d0] = *reinterpret_cast<const bf16x8*>(&Qw[(long)r32 * ZP + d0 * 16 + hi * 8]);
}
__device__ __forceinline__ void sel_kload(f32x4 (&kv)[2], int b, int h, const float* __restrict__ kpart, int tid) {
    const float* kp = kpart + (size_t)((b * 8 + h) * 32) * 128 + (tid >> 4) * 128 + (tid & 15) * 4; kv[0] = *(const f32x4*)kp; kv[1] = *(const f32x4*)(kp + 64); }
__device__ __forceinline__ void sel_kstore(const f32x4 (&kv)[2], LAS bf16* ks, int tid) {
    const f32x4 a = kv[0] + kv[1]; const float v[4] = {a.x, a.y, a.z, a.w}; unsigned hb[4], lb[4];
#pragma unroll
    for (int j = 0; j < 4; ++j) { hb[j] = bfhi(v[j]); lb[j] = bfhi(v[j] - __builtin_bit_cast(float, hb[j] << 16)); }
    LAS bf16* p = ks + (tid >> 4) * SKP + (tid & 15) * 4;
    typedef unsigned v2u_ __attribute__((ext_vector_type(2)));
    *(LAS v2u_*)p = (v2u_){hb[0] | (hb[1] << 16), hb[2] | (hb[3] << 16)}; *(LAS v2u_*)(p + 32 * SKP) = (v2u_){lb[0] | (lb[1] << 16), lb[2] | (lb[3] << 16)}; }
__device__ __forceinline__ void sel_pick(const SelIn& in, const LAS bf16* ks, SelOut& out, int bh, int qb, unsigned* __restrict__ selcnt, int lane, int hi) {
    unsigned selmask = 0u;
    { f32x16 g = f32x16{};
#pragma unroll
      for (int d0 = 0; d0 < 4; ++d0) {
          const bf16x8 kh = *(const LAS bf16x8*)(ks + (lane & 31) * SKP + d0 * 16 + hi * 8), kl = *(const LAS bf16x8*)(ks + (32 + (lane & 31)) * SKP + d0 * 16 + hi * 8);
          g = __builtin_amdgcn_mfma_f32_32x32x16_bf16(kh, in.qr[d0], g, 0, 0, 0); g = __builtin_amdgcn_mfma_f32_32x32x16_bf16(kl, in.qr[d0], g, 0, 0, 0); }
#pragma unroll
      for (int r = 0; r < 16; ++r) if (crow(r, hi) >= qb) g[r] = -INFINITY;
#pragma unroll
      for (int k = 0; k < 3; ++k) { float bv = -INFINITY; int bi = 0;
#pragma unroll
          for (int r = 0; r < 16; ++r) if (g[r] > bv) { bv = g[r]; bi = crow(r, hi); }
          const float pvv = __shfl_xor(bv, 32); const int pi = __shfl_xor(bi, 32);
          const bool tp = (pvv > bv) || (pvv == bv && pi < bi); const float best = tp ? pvv : bv; const int besti = tp ? pi : bi;
          if (best > -INFINITY) { selmask |= 1u << besti;
#pragma unroll
              for (int r = 0; r < 16; ++r) if (crow(r, hi) == besti) g[r] = -INFINITY; } } }
    out.n0 = out.n1 = out.n2 = out.r0 = out.r1 = out.r2 = out.nj = 0; unsigned mycount = 0u;
    const unsigned long long ltmask = (1ull << lane) - 1ull;
    for (int n = 0; n < qb; ++n) { const bool s = ((selmask >> n) & 1u) && hi == 0; const unsigned long long bal = __ballot(s); const int rank = __popcll(bal & ltmask);
        if (s) { if (out.nj == 0) { out.n0 = n; out.r0 = rank; } else if (out.nj == 1) { out.n1 = n; out.r1 = rank; } else { out.n2 = n; out.r2 = rank; } ++out.nj; }
        if (lane == n) mycount = (unsigned)__popcll(bal); }
    out.base = 0u;
    if (lane < qb && mycount) out.base = atomicAdd(selcnt + bh * 32 + lane, mycount);
}
__device__ __forceinline__ void sel_write(const SelOut& o, int bh, int qb, unsigned* __restrict__ list, int wid, int r32, int hi) {
    const unsigned b0 = __shfl(o.base, o.n0), b1 = __shfl(o.base, o.n1), b2 = __shfl(o.base, o.n2);
    const unsigned t = (unsigned)(qb * QB + wid * QBLK + r32);
    if (hi == 0) { if (o.nj > 0) list[(size_t)(bh * 32 + o.n0) * LCAP + b0 + o.r0] = (t << 2) | 0u; if (o.nj > 1) list[(size_t)(bh * 32 + o.n1) * LCAP + b1 + o.r1] = (t << 2) | 1u; if (o.nj > 2) list[(size_t)(bh * 32 + o.n2) * LCAP + b2 + o.r2] = (t << 2) | 2u; }
}
struct SelKeep { unsigned pk, base; };
__device__ __forceinline__ SelKeep sel_keep(const SelOut& o) { SelKeep k; k.pk = (unsigned)o.n0 | ((unsigned)o.n1 << 5) | ((unsigned)o.n2 << 10) | ((unsigned)o.r0 << 15) | ((unsigned)o.r1 << 20) | ((unsigned)o.r2 << 25) | ((unsigned)o.nj << 30); k.base = o.base; return k; }
__device__ __forceinline__ SelOut sel_unkeep(const SelKeep& k) { SelOut o; o.n0 = k.pk & 31; o.n1 = (k.pk >> 5) & 31; o.n2 = (k.pk >> 10) & 31; o.r0 = (k.pk >> 15) & 31; o.r1 = (k.pk >> 20) & 31; o.r2 = (k.pk >> 25) & 31; o.nj = k.pk >> 30; o.base = k.base; return o; }
__device__ __forceinline__ void sel_front(SelKeep& kA, SelKeep& kB, int b, int hA, int qbA, int hB, int qbB, const bf16* __restrict__ Z, const float* __restrict__ kpart, unsigned* __restrict__ selcnt, LAS unsigned char* shm, const int tid) {
    const int lane = tid & 63, r32 = lane & 31, hi = lane >> 5; const int wid = __builtin_amdgcn_readfirstlane(tid >> 6);
    LAS bf16* ks = (LAS bf16*)shm;
    SelIn iA, iB; SelOut oA, oB; f32x4 kvA[2], kvB[2];
    sel_kload(kvA, b, hA, kpart, tid); sel_kload(kvB, b, hB, kpart, tid);
    sel_load(iA, b, hA, qbA, Z, wid, r32, hi); sel_load(iB, b, hB, qbB, Z, wid, r32, hi);
    __syncthreads();
    sel_kstore(kvA, ks, tid); sel_kstore(kvB, ks + 64 * SKP, tid);
    __syncthreads();
    sel_pick(iA, ks, oA, b * 8 + hA, qbA, selcnt, lane, hi); sel_pick(iB, ks + 64 * SKP, oB, b * 8 + hB, qbB, selcnt, lane, hi);
    kA = sel_keep(oA); kB = sel_keep(oB);
    { LAS unsigned* kp_ = (LAS unsigned*)(shm + 114688) + tid * 2; kp_[0] = kA.pk; kp_[1] = kB.pk; kA.pk = 0u; kB.pk = 0u; }
    __syncthreads();
}
__device__ __forceinline__ void sel_back(SelKeep kA, SelKeep kB, int b, int hA, int qbA, int hB, int qbB, unsigned* __restrict__ list, LAS unsigned char* shm, const int tid) {
    { const LAS unsigned* kp_ = (const LAS unsigned*)(shm + 114688) + tid * 2; kA.pk = kp_[0]; kB.pk = kp_[1]; }
    const int lane = tid & 63, r32 = lane & 31, hi = lane >> 5; const int wid = __builtin_amdgcn_readfirstlane(tid >> 6);
    const SelOut oA = sel_unkeep(kA), oB = sel_unkeep(kB);
    sel_write(oA, b * 8 + hA, qbA, list, wid, r32, hi); sel_write(oB, b * 8 + hB, qbB, list, wid, r32, hi);
}
__device__ __forceinline__ void tiles_prefetch(const bf16* Kh, const bf16* Vh, int tile0, LAS unsigned char* shm, const int lane, const int wid) {
    const unsigned lds0 = (unsigned)(uintptr_t)shm;
    const bf16* ksrc = Kh + (long)lane * ZP + wid * 8 + (long)tile0 * KVBLK * ZP;
    const bf16* vsrc = Vh + (long)(16 * (wid & 3) + (lane >> 2)) * ZP + (wid >> 2) * 32 + (lane & 3) * 8 + (long)tile0 * KVBLK * ZP;
    const unsigned kdst = lds0 + LDS_K + wid * 1024, vdst = lds0 + LDS_V + wid * 1024;
    glds16(ksrc, (unsigned)__builtin_amdgcn_readfirstlane(kdst)); glds16(vsrc, (unsigned)__builtin_amdgcn_readfirstlane(vdst));
    glds16(ksrc + (long)KVBLK * ZP, (unsigned)__builtin_amdgcn_readfirstlane(kdst + SLOTB)); glds16(vsrc + (long)KVBLK * ZP, (unsigned)__builtin_amdgcn_readfirstlane(vdst + SLOTB));
}
template <int MODE> __device__ __forceinline__ void four_tiles(f32x16 (&o)[2], float& l_reg, const bf16x8 (&qr)[4], const bf16* Kh, const bf16* Vh, int tile0, bool active, int qrel,
                                                                LAS unsigned char* shm, const int lane, const int wid) {
    const int r32 = lane & 31, hi = lane >> 5; const unsigned lds0 = (unsigned)(uintptr_t)shm;
    const bf16* ksrc = Kh + (long)lane * ZP + wid * 8 + (long)tile0 * KVBLK * ZP;
    const bf16* vsrc = Vh + (long)(16 * (wid & 3) + (lane >> 2)) * ZP + (wid >> 2) * 32 + (lane & 3) * 8 + (long)tile0 * KVBLK * ZP;
    const unsigned kdst = lds0 + LDS_K + wid * 1024, vdst = lds0 + LDS_V + wid * 1024;
#define MB_DMA_K(t, slot) glds16(ksrc + (long)(t) * KVBLK * ZP, (unsigned)__builtin_amdgcn_readfirstlane(kdst + (slot)))
#define MB_DMA_V(t, slot) glds16(vsrc + (long)(t) * KVBLK * ZP, (unsigned)__builtin_amdgcn_readfirstlane(vdst + (slot)))
    const int vb0 = (int)(lds0 + LDS_V) + ((lane >> 4) & 1) * 32 + (lane & 3) * 8 + (4 * hi + ((lane & 15) >> 2)) * 64;
    const lds_cptr kp0 = (lds_cptr)shm + LDS_K;
    int slot = 0;
#pragma unroll
    for (int t = 0; t < 4; ++t) {
        if (t + 1 < 4) MB_WAIT_BAR(2); else MB_WAIT_BAR(0);
        if (t + 2 < 4) { const int s2 = slot >= SLOTB ? slot - SLOTB : slot + 2 * SLOTB; MB_DMA_K(t + 2, s2); MB_DMA_V(t + 2, s2); }
        if (active) {
            const f32x16 cin = f32x16{};
            f32x16 p0, p1;
            qkt(p0, p1, kp0 + slot, qr, cin, r32, hi);
            s16x4 vlo[8], vhi[8]; pv_read(vb0 + slot, vlo, vhi);
            if (MODE == 1) { const int kb = 64 * t + 4 * hi;
#pragma unroll
                for (int r = 0; r < 16; ++r) { const int kv = kb + (r & 3) + 8 * (r >> 2); if (kv > qrel) p0[r] = -1e30f; if (kv + 32 > qrel) p1[r] = -1e30f; } }
            float sacc = 0.f;
#pragma unroll
            for (int r = 0; r < 16; ++r) { p0[r] = __builtin_amdgcn_exp2f(p0[r]); p1[r] = __builtin_amdgcn_exp2f(p1[r]); sacc += p0[r] + p1[r]; }
            l_reg += sacc;
            u32x4 pw0, pw1, pw2, pw3;
            pw0 = (u32x4){cvtpk_s(p0[0], p0[1]), cvtpk_s(p0[2], p0[3]), cvtpk_s(p0[4], p0[5]), cvtpk_s(p0[6], p0[7])};
            pw1 = (u32x4){cvtpk_s(p0[8], p0[9]), cvtpk_s(p0[10], p0[11]), cvtpk_s(p0[12], p0[13]), cvtpk_s(p0[14], p0[15])};
            pw2 = (u32x4){cvtpk_s(p1[0], p1[1]), cvtpk_s(p1[2], p1[3]), cvtpk_s(p1[4], p1[5]), cvtpk_s(p1[6], p1[7])};
            pw3 = (u32x4){cvtpk_s(p1[8], p1[9]), cvtpk_s(p1[10], p1[11]), cvtpk_s(p1[12], p1[13]), cvtpk_s(p1[14], p1[15])};
            MB_SBAR();
            pv_mma(o, __builtin_bit_cast(bf16x8, pw0), __builtin_bit_cast(bf16x8, pw1), __builtin_bit_cast(bf16x8, pw2), __builtin_bit_cast(bf16x8, pw3), vlo, vhi);
        }
        slot = slot == (NSLOT - 1) * SLOTB ? 0 : slot + SLOTB;
    }
#undef MB_DMA_K
#undef MB_DMA_V
}
__device__ __forceinline__ void sparse_unit(int bh, int n, int chunk, int cnt, const bf16* __restrict__ Z, const unsigned* __restrict__ list, bf16* __restrict__ parto, float* __restrict__ partl, LAS unsigned char* shm, const int tid) {
    const int lane = tid & 63, r32 = lane & 31, hi = lane >> 5; const int wid = __builtin_amdgcn_readfirstlane(tid >> 6);
    const int b = bh >> 3, h = bh & 7; const long rowbase = (long)b * SEQ;
    tiles_prefetch(Z + rowbase * ZP + ZC_AK + h * 64, Z + rowbase * ZP + ZC_AV + h * 64, 4 * n, shm, lane, wid);
    const int e = chunk * 256 + wid * QBLK + r32; const bool valid = e < cnt;
    const unsigned entry = valid ? list[(size_t)(bh * 32 + n) * LCAP + e] : 0u; const int t = (int)(entry >> 2);
    const bool active = (chunk * 256 + wid * QBLK) < cnt;
    const bf16* Qrow = Z + (rowbase + t) * ZP + ZC_AQ + h * 64;
    bf16x8 qr[4];
#pragma unroll
    for (int d0 = 0; d0 < 4; ++d0) qr[d0] = *reinterpret_cast<const bf16x8*>(&Qrow[d0 * 16 + hi * 8]);
    float l_reg = 0.f; f32x16 o[2]; o[0] = f32x16{}; o[1] = f32x16{};
    four_tiles<0>(o, l_reg, qr, Z + rowbase * ZP + ZC_AK + h * 64, Z + rowbase * ZP + ZC_AV + h * 64, 4 * n, active, 0, shm, lane, wid);
    LAS float* wsf = (LAS float*)(shm + LDS_WS) + wid * 64;
    { auto rr = __builtin_amdgcn_permlane32_swap(__float_as_uint(l_reg), __float_as_uint(l_reg), false, false); l_reg = __uint_as_float(rr[0]) + __uint_as_float(rr[1]); }
    if (active) {
        if (hi == 0) wsf[32 + r32] = l_reg; asm volatile("s_waitcnt lgkmcnt(0)" ::: "memory");
        float rli[16];
#pragma unroll
        for (int r = 0; r < 16; ++r) rli[r] = __builtin_amdgcn_rcpf(wsf[32 + crow(r, hi)]);
        LAS bf16* stg = (LAS bf16*)(shm + LDS_OST) + wid * 2048;
#pragma unroll
        for (int r = 0; r < 16; ++r) { const int orow = crow(r, hi);
#pragma unroll
            for (int d0 = 0; d0 < 2; ++d0) stg[orow * 64 + d0 * 32 + r32] = (bf16)bfhi(o[d0][r] * rli[r]); }
        asm volatile("s_waitcnt lgkmcnt(0)" ::: "memory");
        if (hi == 0 && valid) partl[((size_t)bh * SEQ + t) * 3 + (entry & 3u)] = l_reg;
#pragma unroll
        for (int i = 0; i < 4; ++i) { const int row = i * 8 + (lane >> 3), ch = lane & 7; const unsigned er = __shfl(entry, row); const bool vr = __shfl((int)valid, row) != 0;
            const u32x4 v = *(const LAS u32x4*)(stg + row * 64 + ch * 8);
            if (vr) *(u32x4*)(parto + (((size_t)bh * SEQ + (er >> 2)) * 3 + (er & 3u)) * 64 + ch * 8) = v; }
    }
    asm volatile("s_waitcnt lgkmcnt(0)\n\ts_barrier" ::: "memory");
}
__device__ __forceinline__ void own_unit(int b, int h, int qb, const bf16* __restrict__ Z, const bf16* __restrict__ parto, const float* __restrict__ partl, bf16* __restrict__ mix, LAS unsigned char* shm, const int tid) {
    const int lane = tid & 63, r32 = lane & 31, hi = lane >> 5; const int wid = __builtin_amdgcn_readfirstlane(tid >> 6);
    const long rowbase = (long)b * SEQ; const int q0 = qb * QB, bh = b * 8 + h;
    tiles_prefetch(Z + rowbase * ZP + ZC_AK + h * 64, Z + rowbase * ZP + ZC_AV + h * 64, 4 * qb, shm, lane, wid);
    const bf16* Qw = Z + (rowbase + q0 + wid * QBLK) * ZP + ZC_AQ + h * 64;
    bf16x8 qr[4];
#pragma unroll
    for (int d0 = 0; d0 < 4; ++d0) qr[d0] = *reinterpret_cast<const bf16x8*>(&Qw[(long)r32 * ZP + d0 * 16 + hi * 8]);
    const int nv = qb < 3 ? qb : 3;
    v4u pp[4][3]; float pl[4][3];
#pragma unroll
    for (int i = 0; i < 4; ++i) { const size_t pr = ((size_t)bh * SEQ + q0 + wid * QBLK + i * 8 + (lane >> 3)) * 3;
#pragma unroll
        for (int j = 0; j < 3; ++j) { pl[i][j] = partl[pr + j]; pp[i][j] = *(const v4u*)(parto + (pr + j) * 64 + (lane & 7) * 8); } }
    float l_reg = 0.f; f32x16 o[2]; o[0] = f32x16{}; o[1] = f32x16{};
    four_tiles<1>(o, l_reg, qr, Z + rowbase * ZP + ZC_AK + h * 64, Z + rowbase * ZP + ZC_AV + h * 64, 4 * qb, true, wid * QBLK + r32, shm, lane, wid);
    LAS float* wsf = (LAS float*)(shm + LDS_WS) + wid * 64;
    { auto rr = __builtin_amdgcn_permlane32_swap(__float_as_uint(l_reg), __float_as_uint(l_reg), false, false); l_reg = __uint_as_float(rr[0]) + __uint_as_float(rr[1]); }
    if (hi == 0) wsf[32 + r32] = l_reg;
    LAS float* stg = (LAS float*)(shm + LDS_OST32) + wid * 2048;
#pragma unroll
    for (int r = 0; r < 16; ++r) { const int orow = crow(r, hi);
#pragma unroll
        for (int d0 = 0; d0 < 2; ++d0) stg[orow * 64 + d0 * 32 + r32] = o[d0][r]; }
    asm volatile("s_waitcnt lgkmcnt(0)" ::: "memory");
    bf16* Ow = mix + (rowbase + q0 + wid * QBLK) * DM + MC_AT + h * 64;
#pragma unroll
    for (int i = 0; i < 4; ++i) { const int row = i * 8 + (lane >> 3), ch = lane & 7;
        f32x4 a0 = *(const LAS f32x4*)(stg + row * 64 + ch * 8), a1 = *(const LAS f32x4*)(stg + row * 64 + ch * 8 + 4); float lt = wsf[32 + row];
#pragma unroll
        for (int j = 0; j < 3; ++j) { const bool on = j < nv; const float lj = on ? pl[i][j] : 0.f; v4u pv_ = pp[i][j]; if (!on) pv_ = (v4u){0u, 0u, 0u, 0u}; lt += lj;
            a0.x += lj * bf2f(pv_.x); a0.y += lj * bf2f(pv_.x >> 16); a0.z += lj * bf2f(pv_.y); a0.w += lj * bf2f(pv_.y >> 16);
            a1.x += lj * bf2f(pv_.z); a1.y += lj * bf2f(pv_.z >> 16); a1.z += lj * bf2f(pv_.w); a1.w += lj * bf2f(pv_.w >> 16); }
        const float rl = __builtin_amdgcn_rcpf(lt);
        v4u ov; ov.x = cvtpk_s(a0.x * rl, a0.y * rl); ov.y = cvtpk_s(a0.z * rl, a0.w * rl); ov.z = cvtpk_s(a1.x * rl, a1.y * rl); ov.w = cvtpk_s(a1.z * rl, a1.w * rl);
        *(v4u*)(Ow + (long)row * DM + ch * 8) = ov; }
    asm volatile("s_waitcnt lgkmcnt(0)\n\ts_barrier" ::: "memory");
}
struct SUnit { int li, chunk, cnt; };
__device__ __forceinline__ SUnit s2_decode(int u, const LAS unsigned* pre, const unsigned* __restrict__ selcnt_l, int h) {
    int lo = 0, hi = 256;
    while (hi - lo > 1) { const int mid = (lo + hi) >> 1; if ((int)pre[mid] <= u) lo = mid; else hi = mid; }
    SUnit s; s.li = 256 * h + lo; s.chunk = u - (int)pre[lo]; s.cnt = (int)selcnt_l[s.li]; return s;
}
__device__ __forceinline__ void sparse_stream(int u0, int ustride, int total, int h, const LAS unsigned* pre, const unsigned* __restrict__ selcnt_l, const bf16* __restrict__ Z, const unsigned* __restrict__ list,
                                              bf16* __restrict__ parto, float* __restrict__ partl, LAS unsigned char* shm, const int tid) {
    if (u0 >= total) return;
    const int lane = tid & 63, r32 = lane & 31, hi = lane >> 5; const int wid = __builtin_amdgcn_readfirstlane(tid >> 6);
    const unsigned lds0 = (unsigned)(uintptr_t)shm;
    const unsigned kdst = lds0 + LDS_K + wid * 1024, vdst = lds0 + LDS_V + wid * 1024;
    const long klane = (long)lane * ZP + wid * 8 + ZC_AK, vlane = (long)(16 * (wid & 3) + (lane >> 2)) * ZP + (wid >> 2) * 32 + (lane & 3) * 8 + ZC_AV;
    const int vb0 = (int)(lds0 + LDS_V) + ((lane >> 4) & 1) * 32 + (lane & 3) * 8 + (4 * hi + ((lane & 15) >> 2)) * 64;
    const lds_cptr kp0 = (lds_cptr)shm + LDS_K;
    LAS float* wsf = (LAS float*)(shm + LDS_WS) + wid * 64;
    LAS bf16* stg = (LAS bf16*)(shm + LDS_OST) + wid * 2048;
#define S2_DMA(U, tl, sl) do { const long rb_ = ((long)((U).li >> 8) * SEQ + (long)(4 * ((U).li & 31) + (tl)) * KVBLK) * ZP + (((U).li >> 5) & 7) * 64; \
        glds16(Z + rb_ + klane, (unsigned)__builtin_amdgcn_readfirstlane(kdst + (sl))); glds16(Z + rb_ + vlane, (unsigned)__builtin_amdgcn_readfirstlane(vdst + (sl))); } while (0)
    SUnit cu = s2_decode(u0, pre, selcnt_l, h);
    S2_DMA(cu, 0, 0); S2_DMA(cu, 1, SLOTB);
    unsigned entry; bool valid; bf16x8 qr[4];
    { const int e = cu.chunk * 256 + wid * QBLK + r32; valid = e < cu.cnt; entry = valid ? list[(size_t)cu.li * LCAP + e] : 0u;
      const bf16* Qrow = Z + ((long)(cu.li >> 8) * SEQ + (long)(entry >> 2)) * ZP + ZC_AQ + ((cu.li >> 5) & 7) * 64;
#pragma unroll
      for (int d0 = 0; d0 < 4; ++d0) qr[d0] = *reinterpret_cast<const bf16x8*>(&Qrow[d0 * 16 + hi * 8]); }
    int slot = 0;
    for (int u = u0;;) {
        const int un = u + ustride; const bool has_next = un < total;
        SUnit nu = cu; if (has_next) nu = s2_decode(un, pre, selcnt_l, h);
        unsigned nentry = 0u; bool nvalid = false; bf16x8 nqr[4];
#pragma unroll
        for (int d0 = 0; d0 < 4; ++d0) nqr[d0] = qr[d0];
        const bool active = (cu.chunk * 256 + wid * QBLK) < cu.cnt;
        float l_reg = 0.f; f32x16 o[2]; o[0] = f32x16{}; o[1] = f32x16{};
#pragma unroll
        for (int t = 0; t < 4; ++t) {
            if (t < 3) MB_WAIT_BAR(2); else { if (has_next) MB_WAIT_BAR(2); else MB_WAIT_BAR(0); }
            if (t == 1 && has_next) { const int e = nu.chunk * 256 + wid * QBLK + r32; nvalid = e < nu.cnt; nentry = nvalid ? list[(size_t)nu.li * LCAP + e] : 0u; }
            if (t == 3 && has_next) { const bf16* Qrow = Z + ((long)(nu.li >> 8) * SEQ + (long)(nentry >> 2)) * ZP + ZC_AQ + ((nu.li >> 5) & 7) * 64;
#pragma unroll
                for (int d0 = 0; d0 < 4; ++d0) nqr[d0] = *reinterpret_cast<const bf16x8*>(&Qrow[d0 * 16 + hi * 8]); }
            { const int s2 = slot >= SLOTB ? slot - SLOTB : slot + 2 * SLOTB;
              if (t + 2 < 4) S2_DMA(cu, t + 2, s2); else if (has_next) S2_DMA(nu, t - 2, s2); }
            if (active) {
                const f32x16 cin = f32x16{};
                f32x16 p0, p1;
                qkt(p0, p1, kp0 + slot, qr, cin, r32, hi);
                s16x4 vlo[8], vhi[8]; pv_read(vb0 + slot, vlo, vhi);
                float sacc = 0.f;
#pragma unroll
                for (int r = 0; r < 16; ++r) { p0[r] = __builtin_amdgcn_exp2f(p0[r]); p1[r] = __builtin_amdgcn_exp2f(p1[r]); sacc += p0[r] + p1[r]; }
                l_reg += sacc;
                u32x4 pw0, pw1, pw2, pw3;
                pw0 = (u32x4){cvtpk_s(p0[0], p0[1]), cvtpk_s(p0[2], p0[3]), cvtpk_s(p0[4], p0[5]), cvtpk_s(p0[6], p0[7])};
                pw1 = (u32x4){cvtpk_s(p0[8], p0[9]), cvtpk_s(p0[10], p0[11]), cvtpk_s(p0[12], p0[13]), cvtpk_s(p0[14], p0[15])};
                pw2 = (u32x4){cvtpk_s(p1[0], p1[1]), cvtpk_s(p1[2], p1[3]), cvtpk_s(p1[4], p1[5]), cvtpk_s(p1[6], p1[7])};
                pw3 = (u32x4){cvtpk_s(p1[8], p1[9]), cvtpk_s(p1[10], p1[11]), cvtpk_s(p1[12], p1[13]), cvtpk_s(p1[14], p1[15])};
                MB_SBAR();
                pv_mma(o, __builtin_bit_cast(bf16x8, pw0), __builtin_bit_cast(bf16x8, pw1), __builtin_bit_cast(bf16x8, pw2), __builtin_bit_cast(bf16x8, pw3), vlo, vhi);
            }
            slot = slot == (NSLOT - 1) * SLOTB ? 0 : slot + SLOTB;
        }
        { auto rr = __builtin_amdgcn_permlane32_swap(__float_as_uint(l_reg), __float_as_uint(l_reg), false, false); l_reg = __uint_as_float(rr[0]) + __uint_as_float(rr[1]); }
        if (active) {
            const int bh = cu.li >> 5;
            if (hi == 0) wsf[32 + r32] = l_reg; asm volatile("s_waitcnt lgkmcnt(0)" ::: "memory");
            float rli[16];
#pragma unroll
            for (int r = 0; r < 16; ++r) rli[r] = __builtin_amdgcn_rcpf(wsf[32 + crow(r, hi)]);
#pragma unroll
            for (int r = 0; r < 16; ++r) { const int orow = crow(r, hi);
#pragma unroll
                for (int d0 = 0; d0 < 2; ++d0) stg[orow * 64 + d0 * 32 + r32] = (bf16)bfhi(o[d0][r] * rli[r]); }
            asm volatile("s_waitcnt lgkmcnt(0)" ::: "memory");
            if (hi == 0 && valid) partl[((size_t)bh * SEQ + (entry >> 2)) * 3 + (entry & 3u)] = l_reg;
#pragma unroll
            for (int i = 0; i < 4; ++i) { const int row = i * 8 + (lane >> 3), ch = lane & 7; const unsigned er = __shfl(entry, row); const bool vr = __shfl((int)valid, row) != 0;
                const u32x4 v = *(const LAS u32x4*)(stg + row * 64 + ch * 8);
                if (vr) *(u32x4*)(parto + (((size_t)bh * SEQ + (er >> 2)) * 3 + (er & 3u)) * 64 + ch * 8) = v; }
            asm volatile("s_waitcnt lgkmcnt(0)" ::: "memory");
        }
        if (!has_next) break;
        cu = nu; entry = nentry; valid = nvalid; u = un;
#pragma unroll
        for (int d0 = 0; d0 < 4; ++d0) qr[d0] = nqr[d0];
    }
    asm volatile("s_waitcnt lgkmcnt(0)\n\ts_barrier" ::: "memory");
#undef S2_DMA
}
}

namespace mlx {
typedef short bf16x8 __attribute__((ext_vector_type(8)));
typedef short bf16x4 __attribute__((ext_vector_type(4)));
typedef float f32x4 __attribute__((ext_vector_type(4)));
constexpr int L = 128, NC = SEQ / L;
constexpr float LOG2E = 1.4426950408889634f;
__device__ __forceinline__ float silu_(float x) { return x * __builtin_amdgcn_rcpf(1.f + __builtin_amdgcn_exp2f(-LOG2E * x)); }
__device__ __forceinline__ float logsig_(float x) { return fminf(x, 0.f) - __logf(1.f + __expf(-fabsf(x))); }
__device__ __forceinline__ float scan_add64(float x, int lane) {
#pragma unroll
    for (int o = 1; o < 64; o <<= 1) { const float v = __shfl_up(x, o); if (lane >= o) x += v; }
    return x; }
__device__ __forceinline__ float scan_max64(float x, int lane) {
#pragma unroll
    for (int o = 1; o < 64; o <<= 1) { const float v = __shfl_up(x, o); if (lane >= o) x = fmaxf(x, v); }
    return x; }
__device__ __forceinline__ void conv8_load(const bf16* zp, int t, v4u (&zv)[4]) {
#pragma unroll
    for (int j = 0; j < 4; ++j) zv[j] = *(const v4u*)(zp + (t - 3 + j >= 0 ? (long)(j - 3) * ZP : 0l));
}
__device__ __forceinline__ void conv8_math(const v4u (&zv)[4], int t, const float* w, float (&y)[8]) {
#pragma unroll
    for (int i = 0; i < 8; ++i) y[i] = 0.f;
#pragma unroll
    for (int j = 0; j < 4; ++j) { const float ok = t - 3 + j >= 0 ? 1.f : 0.f; const f32x4 w0 = *(const f32x4*)(w + j * 512) * ok, w1 = *(const f32x4*)(w + j * 512 + 4) * ok;
        y[0] += w0.x * bf2f(zv[j].x); y[1] += w0.y * bf2f(zv[j].x >> 16); y[2] += w0.z * bf2f(zv[j].y); y[3] += w0.w * bf2f(zv[j].y >> 16);
        y[4] += w1.x * bf2f(zv[j].z); y[5] += w1.y * bf2f(zv[j].z >> 16); y[6] += w1.z * bf2f(zv[j].w); y[7] += w1.w * bf2f(zv[j].w >> 16); }
#pragma unroll
    for (int i = 0; i < 8; ++i) y[i] = silu_(y[i]);
}
constexpr int PQ = 72, PV_ = 136;
constexpr int O_QS = 0, O_KS = O_QS + 128 * PQ * 2, O_VT = O_KS + 128 * PQ * 2, O_CT = O_VT + 64 * PV_ * 2, O_F = O_CT + 64 * PQ * 2;
constexpr int F_G = 0, F_U = 128, F_W = 256, F_M = 384, F_A = 512, F_E = 640, F_QN = 768, F_DEN = 896, F_TMP = 1024, F_NP = 1040, F_END = 1104;
constexpr int O_STG = O_F + F_END * 4;
constexpr int LDS_NEED = O_STG + 8 * 4096;

__device__ __forceinline__ void unit_a(int bh, int c, int l, const bf16* __restrict__ Z, const float* __restrict__ gates, const float* __restrict__ mconv,
                                       float* __restrict__ DLOC, float* __restrict__ NLOC, float* __restrict__ SCAL, LAS unsigned char* shm, const int tid) {
    const int lane = tid & 63, wid = __builtin_amdgcn_readfirstlane(tid >> 6), b = bh >> 2, h = bh & 3;
    const long row0 = (long)b * SEQ + (long)c * L;
    LAS float* F = (LAS float*)(shm + O_F); LAS bf16* Ktw = (LAS bf16*)(shm + O_KS); LAS bf16* Vt = (LAS bf16*)(shm + O_VT);
    v4u zk[2][4], vv[2];
#pragma unroll
    for (int i = 0; i < 2; ++i) { const int item = tid + 512 * i, s = item >> 3, dg = item & 7;
        conv8_load(Z + (row0 + s) * ZP + ZC_MK + 64 * h + 8 * dg, c * L + s, zk[i]); vv[i] = *(const v4u*)(Z + (row0 + s) * ZP + ZC_MV + 64 * h + 8 * dg); }
    float gs = 0.f, us = 0.f;
    if (tid < 128) { const float ip = gates[(row0 + tid) * 8 + h], fp = gates[(row0 + tid) * 8 + 4 + h]; gs = scan_add64(logsig_(fp), lane); us = ip; if (tid == 63) F[F_TMP] = gs; }
    __syncthreads();
    if (tid < 128) { if (tid >= 64) gs += F[F_TMP]; us -= gs; F[F_U + tid] = us; if (tid == 127) F[F_TMP + 1] = gs; float mx = us;
#pragma unroll
        for (int o = 1; o < 64; o <<= 1) mx = fmaxf(mx, __shfl_xor(mx, o));
        if (lane == 0) F[F_TMP + 2 + wid] = mx; }
    __syncthreads();
    const float gl = F[F_TMP + 1], mloc = gl + fmaxf(F[F_TMP + 2], F[F_TMP + 3]);
    if (tid < 128) F[F_W + tid] = __expf(gl + us - mloc);
    __syncthreads();
#pragma unroll
    for (int i = 0; i < 2; ++i) { const int item = tid + 512 * i, s = item >> 3, dg = item & 7; float y[8];
        conv8_math(zk[i], c * L + s, mconv + 256 + 64 * h + 8 * dg, y);
        const float wk = F[F_W + s] * 0.125f;
#pragma unroll
        for (int j = 0; j < 8; ++j) Ktw[(8 * dg + j) * PV_ + s] = (bf16)f2bf(y[j] * wk);
        const v4u v1 = vv[i];
        Vt[(8 * dg + 0) * PV_ + s] = (bf16)(v1.x & 0xffffu); Vt[(8 * dg + 1) * PV_ + s] = (bf16)(v1.x >> 16); Vt[(8 * dg + 2) * PV_ + s] = (bf16)(v1.y & 0xffffu); Vt[(8 * dg + 3) * PV_ + s] = (bf16)(v1.y >> 16);
        Vt[(8 * dg + 4) * PV_ + s] = (bf16)(v1.z & 0xffffu); Vt[(8 * dg + 5) * PV_ + s] = (bf16)(v1.z >> 16); Vt[(8 * dg + 6) * PV_ + s] = (bf16)(v1.w & 0xffffu); Vt[(8 * dg + 7) * PV_ + s] = (bf16)(v1.w >> 16); }
    __syncthreads();
    { const int dt = wid >> 1, fr = lane & 15, q4 = lane >> 4; f32x4 acc[2] = {(f32x4){0.f, 0.f, 0.f, 0.f}, (f32x4){0.f, 0.f, 0.f, 0.f}};
#pragma unroll
      for (int ks = 0; ks < 4; ++ks) { const bf16x8 a = *(const LAS bf16x8*)(Ktw + (16 * dt + fr) * PV_ + 32 * ks + 8 * q4);
#pragma unroll
          for (int et = 0; et < 2; ++et) { const bf16x8 bb = *(const LAS bf16x8*)(Vt + (16 * (2 * (wid & 1) + et) + fr) * PV_ + 32 * ks + 8 * q4); acc[et] = __builtin_amdgcn_mfma_f32_16x16x32_bf16(a, bb, acc[et], 0, 0, 0); } }
      float* dp = DLOC + ((size_t)(bh * NC + c) * 64) * 64;
#pragma unroll
      for (int et = 0; et < 2; ++et) *(f32x4*)(dp + (16 * (2 * (wid & 1) + et) + fr) * 64 + 16 * dt + 4 * q4) = acc[et]; }
    { const int d = tid & 63, part = tid >> 6; const v4u k0 = *(const LAS v4u*)(Ktw + d * PV_ + 16 * part), k1 = *(const LAS v4u*)(Ktw + d * PV_ + 16 * part + 8);
      float s = ((bf2f(k0.x) + bf2f(k0.x >> 16)) + (bf2f(k0.y) + bf2f(k0.y >> 16))) + ((bf2f(k0.z) + bf2f(k0.z >> 16)) + (bf2f(k0.w) + bf2f(k0.w >> 16)));
      s += ((bf2f(k1.x) + bf2f(k1.x >> 16)) + (bf2f(k1.y) + bf2f(k1.y >> 16))) + ((bf2f(k1.z) + bf2f(k1.z >> 16)) + (bf2f(k1.w) + bf2f(k1.w >> 16)));
      F[F_G + part * 64 + d] = s; }
    __syncthreads();
    if (tid < 64) { float s = 0.f;
#pragma unroll
        for (int p = 0; p < 8; ++p) s += F[F_G + p * 64 + tid];
        NLOC[(size_t)(bh * NC + c) * 64 + tid] = s; }
    if (tid == 64) { SCAL[(bh * NC + c) * 2] = gl; SCAL[(bh * NC + c) * 2 + 1] = mloc; }
    __syncthreads();
}
__device__ __forceinline__ void unit_b(int v, const float* __restrict__ DLOC, const float* __restrict__ NLOC, const float* __restrict__ SCAL, bf16* __restrict__ CT, float* __restrict__ NPREV, float* __restrict__ MPREV,
                                       LAS float* sc  , const int tid) {
    const int bh = v >> 5, sl = v & 31;
    const bool isC = tid < 128, isN = sl == 0 && tid >= 128 && tid < 192, on = isC || isN;
    if (tid < 128) sc[tid] = SCAL[bh * NC * 2 + tid];
    const float* src = isC ? DLOC + (size_t)bh * NC * 4096 + sl * 128 + tid : NLOC + (size_t)bh * NC * 64 + (isN ? tid - 128 : 0);
    const int stride = isC ? 4096 : 64;
    float dv[NC];
#pragma unroll
    for (int c = 0; c < NC; ++c) dv[c] = on ? src[(size_t)c * stride] : 0.f;
    __syncthreads();
    float st = 0.f, m = 0.f;
#pragma unroll
    for (int c = 0; c < NC; ++c) { const float gl = sc[2 * c], mloc = sc[2 * c + 1];
        if (isC) CT[(size_t)(bh * NC + c) * 4096 + sl * 128 + tid] = (bf16)f2bf(st); else if (isN) { NPREV[(size_t)(bh * NC + c) * 64 + (tid - 128)] = st; if (tid == 128) MPREV[bh * NC + c] = m; }
        const float mn = fmaxf(gl + m, mloc); st = __expf(gl + m - mn) * st + __expf(mloc - mn) * dv[c]; m = mn; }
    __syncthreads();
}
__device__ __forceinline__ void unit_c(int bh, int c, int l, const bf16* __restrict__ Z, const float* __restrict__ gates, const float* __restrict__ mconv, const float* __restrict__ ng,
                                       const bf16* __restrict__ CT, const float* __restrict__ NPREV, const float* __restrict__ MPREV, bf16* __restrict__ mix, LAS unsigned char* shm, const int tid) {
    const int lane = tid & 63, wid = __builtin_amdgcn_readfirstlane(tid >> 6), b = bh >> 2, h = bh & 3, fr = lane & 15, q4 = lane >> 4;
    const long row0 = (long)b * SEQ + (long)c * L;
    LAS float* F = (LAS float*)(shm + O_F); LAS bf16* Qs = (LAS bf16*)(shm + O_QS); LAS bf16* Ks = (LAS bf16*)(shm + O_KS); LAS bf16* Vt = (LAS bf16*)(shm + O_VT); LAS bf16* Ct = (LAS bf16*)(shm + O_CT);
    const float mprev = MPREV[bh * NC + c];
    v4u zq[2][4], zk[2][4], vv[2];
#pragma unroll
    for (int i = 0; i < 2; ++i) { const int item = tid + 512 * i, s = item >> 3, dg = item & 7;
        conv8_load(Z + (row0 + s) * ZP + ZC_MQ + 64 * h + 8 * dg, c * L + s, zq[i]); conv8_load(Z + (row0 + s) * ZP + ZC_MK + 64 * h + 8 * dg, c * L + s, zk[i]);
        vv[i] = *(const v4u*)(Z + (row0 + s) * ZP + ZC_MV + 64 * h + 8 * dg); }
    const v4u ctv = *(const v4u*)(CT + (size_t)(bh * NC + c) * 4096 + (tid >> 3) * 64 + (tid & 7) * 8);
    float gs = 0.f, us = 0.f, bm = 0.f;
    if (tid < 128) { const float ip = gates[(row0 + tid) * 8 + h], fp = gates[(row0 + tid) * 8 + 4 + h]; gs = scan_add64(logsig_(fp), lane); us = ip; if (tid == 63) F[F_TMP] = gs; }
    else if (tid < 192) F[F_NP + (tid - 128)] = NPREV[(size_t)(bh * NC + c) * 64 + (tid - 128)];
    __syncthreads();
    if (tid < 128) { if (tid >= 64) gs += F[F_TMP]; us -= gs; bm = scan_max64(us, lane); if (tid == 63) F[F_TMP + 1] = bm; }
    __syncthreads();
    if (tid < 128) { if (tid >= 64) bm = fmaxf(bm, F[F_TMP + 1]); const float Mt = fmaxf(mprev, bm);
        F[F_G + tid] = gs; F[F_U + tid] = us * LOG2E; F[F_M + tid] = Mt * LOG2E; F[F_A + tid] = __expf(mprev - Mt); F[F_E + tid] = __expf(-(gs + Mt)); }
#pragma unroll
    for (int i = 0; i < 2; ++i) { const int item = tid + 512 * i, s = item >> 3, dg = item & 7; float y[8];
        conv8_math(zq[i], c * L + s, mconv + 64 * h + 8 * dg, y);
        v4u o; o.x = pk2(y[0], y[1]); o.y = pk2(y[2], y[3]); o.z = pk2(y[4], y[5]); o.w = pk2(y[6], y[7]); *(LAS v4u*)(Qs + s * PQ + 8 * dg) = o;
        conv8_math(zk[i], c * L + s, mconv + 256 + 64 * h + 8 * dg, y);
        o.x = pk2(y[0] * 0.125f, y[1] * 0.125f); o.y = pk2(y[2] * 0.125f, y[3] * 0.125f); o.z = pk2(y[4] * 0.125f, y[5] * 0.125f); o.w = pk2(y[6] * 0.125f, y[7] * 0.125f); *(LAS v4u*)(Ks + s * PQ + 8 * dg) = o;
        const v4u v1 = vv[i];
        Vt[(8 * dg + 0) * PV_ + s] = (bf16)(v1.x & 0xffffu); Vt[(8 * dg + 1) * PV_ + s] = (bf16)(v1.x >> 16); Vt[(8 * dg + 2) * PV_ + s] = (bf16)(v1.y & 0xffffu); Vt[(8 * dg + 3) * PV_ + s] = (bf16)(v1.y >> 16);
        Vt[(8 * dg + 4) * PV_ + s] = (bf16)(v1.z & 0xffffu); Vt[(8 * dg + 5) * PV_ + s] = (bf16)(v1.z >> 16); Vt[(8 * dg + 6) * PV_ + s] = (bf16)(v1.w & 0xffffu); Vt[(8 * dg + 7) * PV_ + s] = (bf16)(v1.w >> 16); }
    { const int e = tid >> 3, d8 = (tid & 7) * 8; *(LAS v4u*)(Ct + e * PQ + d8) = ctv; }
    __syncthreads();
    if (tid < 128) { float s = 0.f;
#pragma unroll 8
        for (int d = 0; d < 64; ++d) s += bf2f(Qs[tid * PQ + d]) * F[F_NP + d];
        F[F_QN + tid] = s; }
    const int w = wid; const int tl = 16 * w + fr;
    bf16x8 qf[2];
#pragma unroll
    for (int ks = 0; ks < 2; ++ks) qf[ks] = *(const LAS bf16x8*)(Qs + tl * PQ + 32 * ks + 8 * q4);
    const float M2 = F[F_M + tl];
    f32x4 num[4] = {(f32x4){0.f, 0.f, 0.f, 0.f}, (f32x4){0.f, 0.f, 0.f, 0.f}, (f32x4){0.f, 0.f, 0.f, 0.f}, (f32x4){0.f, 0.f, 0.f, 0.f}};
    float dsum = 0.f;
    for (int i = 0; i <= (w >> 1); ++i) {
        unsigned pw[4];
#pragma unroll
        for (int hf = 0; hf < 2; ++hf) { const int j = 2 * i + hf; f32x4 sv = (f32x4){0.f, 0.f, 0.f, 0.f};
            if (j <= w) {
#pragma unroll
                for (int ks = 0; ks < 2; ++ks) { const bf16x8 kf = *(const LAS bf16x8*)(Ks + (16 * j + fr) * PQ + 32 * ks + 8 * q4); sv = __builtin_amdgcn_mfma_f32_16x16x32_bf16(kf, qf[ks], sv, 0, 0, 0); }
                const f32x4 u2 = *(const LAS f32x4*)(F + F_U + 16 * j + 4 * q4);
#pragma unroll
                for (int r = 0; r < 4; ++r) { float wv = sv[r] * __builtin_amdgcn_exp2f(u2[r] - M2); if (j == w && 4 * q4 + r > fr) wv = 0.f; sv[r] = wv; dsum += wv; } }
            pw[2 * hf] = pg8::cvtpk(sv[0], sv[1]); pw[2 * hf + 1] = pg8::cvtpk(sv[2], sv[3]); }
        const bf16x8 wa = __builtin_bit_cast(bf16x8, (v4u){pw[0], pw[1], pw[2], pw[3]});
#pragma unroll
        for (int et = 0; et < 4; ++et) { const bf16x4 v0 = *(const LAS bf16x4*)(Vt + (16 * et + fr) * PV_ + 32 * i + 4 * q4), v1 = *(const LAS bf16x4*)(Vt + (16 * et + fr) * PV_ + 32 * i + 16 + 4 * q4);
            const bf16x8 vb = (bf16x8){v0[0], v0[1], v0[2], v0[3], v1[0], v1[1], v1[2], v1[3]};
            num[et] = __builtin_amdgcn_mfma_f32_16x16x32_bf16(wa, vb, num[et], 0, 0, 0); }
    }
    dsum += __shfl_xor(dsum, 16); dsum += __shfl_xor(dsum, 32);
    __syncthreads();
    if (q4 == 0) F[F_DEN + tl] = dsum + F[F_A + tl] * F[F_QN + tl];
    f32x4 inter[4];
#pragma unroll
    for (int et = 0; et < 4; ++et) { inter[et] = (f32x4){0.f, 0.f, 0.f, 0.f};
#pragma unroll
        for (int ks = 0; ks < 2; ++ks) { const bf16x8 cf = *(const LAS bf16x8*)(Ct + (16 * et + fr) * PQ + 32 * ks + 8 * q4); inter[et] = __builtin_amdgcn_mfma_f32_16x16x32_bf16(qf[ks], cf, inter[et], 0, 0, 0); } }
    asm volatile("s_waitcnt lgkmcnt(0)" ::: "memory");
    LAS float* stg = (LAS float*)(shm + O_STG) + w * 1024;
#pragma unroll
    for (int r = 0; r < 4; ++r) { const int t = 16 * w + 4 * q4 + r; const float a = F[F_A + t], den = F[F_DEN + t], dn = __builtin_amdgcn_rcpf(fmaxf(fabsf(den), F[F_E + t]));
        float hv[4], ss = 0.f;
#pragma unroll
        for (int et = 0; et < 4; ++et) { hv[et] = (num[et][r] + a * inter[et][r]) * dn; ss += hv[et] * hv[et]; }
        ss += __shfl_xor(ss, 1); ss += __shfl_xor(ss, 2); ss += __shfl_xor(ss, 4); ss += __shfl_xor(ss, 8);
        const float rn = rsqrtf(ss * (1.f / 64.f) + 1e-6f);
#pragma unroll
        for (int et = 0; et < 4; ++et) stg[(4 * q4 + r) * 64 + 16 * et + fr] = hv[et] * rn; }
    asm volatile("s_waitcnt lgkmcnt(0)" ::: "memory");
#pragma unroll
    for (int p = 0; p < 2; ++p) { const int rr = 8 * p + (lane >> 3), e8 = (lane & 7) * 8; const long row = row0 + 16 * w + rr;
        const f32x4 h0 = *(const LAS f32x4*)(stg + rr * 64 + e8), h1 = *(const LAS f32x4*)(stg + rr * 64 + e8 + 4);
        const f32x4 g0 = *(const f32x4*)(ng + 64 * h + e8), g1 = *(const f32x4*)(ng + 64 * h + e8 + 4);
        const v4u og = *(const v4u*)(Z + row * ZP + ZC_MO + 64 * h + e8);
        v4u o; o.x = pk2(h0.x * g0.x * bf2f(og.x), h0.y * g0.y * bf2f(og.x >> 16)); o.y = pk2(h0.z * g0.z * bf2f(og.y), h0.w * g0.w * bf2f(og.y >> 16));
        o.z = pk2(h1.x * g1.x * bf2f(og.z), h1.y * g1.y * bf2f(og.z >> 16)); o.w = pk2(h1.z * g1.z * bf2f(og.w), h1.w * g1.w * bf2f(og.w >> 16));
        *(v4u*)(mix + row * DM + MC_ML + 64 * h + e8) = o; }
    __syncthreads();
}
}

namespace poolx {
typedef short bf16x8 __attribute__((ext_vector_type(8)));
typedef float f32x4 __attribute__((ext_vector_type(4)));
constexpr int TOK = 64, HALO = 15, PIN = 264, PPW = 72;
constexpr int O_IN = 0, O_PW = 41728, O_OUT = O_PW + 4 * 64 * PPW * 2, LDS_NEED = O_OUT + TOK * PIN * 2;
__device__ __forceinline__ void unit(int u, const bf16* __restrict__ Z, const bf16* __restrict__ PWT, const float* __restrict__ pscale, bf16* __restrict__ mix, LAS unsigned char* shm, const int tid) {
    const int lane = tid & 63, wid = __builtin_amdgcn_readfirstlane(tid >> 6), fr = lane & 15, q4 = lane >> 4;
    const long row0 = (long)u * TOK; const int tpos0 = (int)(row0 % SEQ);
    LAS bf16* ins = (LAS bf16*)(shm + O_IN); LAS bf16* pws = (LAS bf16*)(shm + O_PW); LAS bf16* outs = (LAS bf16*)(shm + O_OUT);
    { v4u zin[5], pwv[4];
#pragma unroll
      for (int k = 0; k < 5; ++k) { const int it = tid + 512 * k, rr = it >> 5, ch = it & 31; const bool ok = it < (TOK + HALO) * 32 && tpos0 - HALO + rr >= 0;
          zin[k] = *(const v4u*)(Z + (ok ? row0 - HALO + rr : row0) * ZP + ZC_POOL + 8 * ch); if (!ok) zin[k] = (v4u){0u, 0u, 0u, 0u}; }
#pragma unroll
      for (int k = 0; k < 4; ++k) { const int it = tid + 512 * k, ro = it >> 3, ch = it & 7; pwv[k] = *(const v4u*)(PWT + ro * 64 + 8 * ch); }
#pragma unroll
      for (int k = 0; k < 5; ++k) { const int it = tid + 512 * k, rr = it >> 5, ch = it & 31; if (it < (TOK + HALO) * 32) *(LAS v4u*)(ins + rr * PIN + 8 * ch) = zin[k]; }
#pragma unroll
      for (int k = 0; k < 4; ++k) { const int it = tid + 512 * k, ro = it >> 3, ch = it & 7; *(LAS v4u*)(pws + ro * PPW + 8 * ch) = pwv[k]; } }
    __syncthreads();
    const int tt = wid & 3, gp = wid >> 2, tloc = 16 * tt + fr, tpos = tpos0 + tloc;
    float scv[2][4];
#pragma unroll
    for (int gi = 0; gi < 2; ++gi)
#pragma unroll
        for (int ot = 0; ot < 4; ++ot) scv[gi][ot] = pscale[64 * (gp == 0 ? 3 * gi : 1 + gi) + 16 * ot + fr];
#pragma unroll
    for (int gi = 0; gi < 2; ++gi) { const int g = gp == 0 ? 3 * gi : 1 + gi  , win = 2 << g; const int cnt = (tpos + 1) < win ? (tpos + 1) : win; const float inv = 1.f / (float)cnt;
        bf16x8 af[2];
#pragma unroll
        for (int ks = 0; ks < 2; ++ks) { const LAS bf16* p = ins + (HALO + tloc) * PIN + 64 * g + 32 * ks + 8 * q4; float s[8];
            const v4u x0 = *(const LAS v4u*)p;
#pragma unroll
            for (int j = 0; j < 8; ++j) s[j] = 0.f;
#pragma unroll 4
            for (int i = 0; i < win; ++i) { const v4u v = *(const LAS v4u*)(p - i * PIN);
                s[0] += bf2f(v.x); s[1] += bf2f(v.x >> 16); s[2] += bf2f(v.y); s[3] += bf2f(v.y >> 16); s[4] += bf2f(v.z); s[5] += bf2f(v.z >> 16); s[6] += bf2f(v.w); s[7] += bf2f(v.w >> 16); }
            v4u o; o.x = pk2(s[0] * inv - bf2f(x0.x), s[1] * inv - bf2f(x0.x >> 16)); o.y = pk2(s[2] * inv - bf2f(x0.y), s[3] * inv - bf2f(x0.y >> 16));
            o.z = pk2(s[4] * inv - bf2f(x0.z), s[5] * inv - bf2f(x0.z >> 16)); o.w = pk2(s[6] * inv - bf2f(x0.w), s[7] * inv - bf2f(x0.w >> 16));
            af[ks] = __builtin_bit_cast(bf16x8, o); }
#pragma unroll
        for (int ot = 0; ot < 4; ++ot) { f32x4 acc = (f32x4){0.f, 0.f, 0.f, 0.f};
#pragma unroll
            for (int ks = 0; ks < 2; ++ks) { const bf16x8 bfr = *(const LAS bf16x8*)(pws + (64 * g + 16 * ot + fr) * PPW + 32 * ks + 8 * q4); acc = __builtin_amdgcn_mfma_f32_16x16x32_bf16(af[ks], bfr, acc, 0, 0, 0); }
            const float sc = scv[gi][ot];
#pragma unroll
            for (int r = 0; r < 4; ++r) outs[(16 * tt + 4 * q4 + r) * PIN + 64 * g + 16 * ot + fr] = (bf16)f2bf(acc[r] * sc); } }
    __syncthreads();
    for (int it = tid; it < TOK * 32; it += 512) { const int rr = it >> 5, ch = it & 31; *(v4u*)(mix + (row0 + rr) * DM + MC_POOL + 8 * ch) = *(const LAS v4u*)(outs + rr * PIN + 8 * ch); }
    __syncthreads();
}
}

constexpr int NWAVES = 8;
constexpr int RING_OFF = 0, RING_BYTES = 131072;
constexpr int LDSCTL_OFF = RING_BYTES, MISC_OFF = LDSCTL_OFF + 320;
constexpr int LDS_BYTES = 147456;
constexpr int CW_CONV = 20480;
constexpr int CW_SEL = 16384;
constexpr int CW_BAR = 4096;
constexpr size_t CTL_ZERO_BYTES = 128 * 1024;
constexpr int N_PHASES = 1 + 7 * DEPTH;
enum { PK_IN = 0, PK_MIX1 = 1, PK_ATT = 2, PK_MLC = 3, PK_OUT = 4, PK_UP = 5, PK_DOWN = 6 };

#ifndef SKIP_PK_IN
#define SKIP_PK_IN 0
#endif
#ifndef SKIP_PK_OUT
#define SKIP_PK_OUT 0
#endif
#ifndef SKIP_PK_UP
#define SKIP_PK_UP 0
#endif
#ifndef SKIP_PK_DOWN
#define SKIP_PK_DOWN 0
#endif
#ifdef PROBE_KIND
#ifndef PROBE_KIND2
#define PROBE_KIND2 PROBE_KIND
#endif
#endif
#ifndef STAGGER_TICKS
#define STAGGER_TICKS 1200ull
#endif
#ifndef SPARSE_ATT
#define SPARSE_ATT 1
#endif
struct Args { const float* in[16]; float* out; unsigned char* ws; int ph_lo, ph_hi; };

struct PItem { const float* W; const float* gain; bf16* out; int K, Norig, r0, k0, mode; bool on; };
__device__ __forceinline__ void pw_load(const PItem& p, int tid, float (&v)[16]) {
    const int rr = p.r0 + (tid & 63); const int oc = p.mode == 0 ? in_orig_col(in_row_to_zc(rr)) : (p.mode == 2 ? up_row_to_orig(rr) : rr); const int occ = oc < 0 ? 0 : oc;
    const float* wp = p.W + (size_t)(p.k0 + (tid >> 6)) * p.Norig + occ;
#pragma unroll
    for (int i = 0; i < 16; ++i) v[i] = wp[(size_t)(4 * i) * p.Norig];
    if (p.gain) {
#pragma unroll
        for (int i = 0; i < 16; ++i) v[i] *= p.gain[p.k0 + (tid >> 6) + 4 * i]; }
    if (oc < 0) {
#pragma unroll
        for (int i = 0; i < 16; ++i) v[i] = 0.f; }
}
__device__ __forceinline__ void pw_store(const PItem& p, LAS float* t, int tid, const float (&v)[16]) {
#pragma unroll
    for (int i = 0; i < 16; ++i) t[((tid >> 6) + 4 * i) * 65 + (tid & 63)] = v[i];
    __syncthreads();
    if (p.on) {
#pragma unroll
    for (int it = 0; it < 2; ++it) { const int r = (tid >> 3) + 32 * it, k8 = (tid & 7) * 8; v4u o;
        o.x = pk2(t[(k8 + 0) * 65 + r], t[(k8 + 1) * 65 + r]); o.y = pk2(t[(k8 + 2) * 65 + r], t[(k8 + 3) * 65 + r]); o.z = pk2(t[(k8 + 4) * 65 + r], t[(k8 + 5) * 65 + r]); o.w = pk2(t[(k8 + 6) * 65 + r], t[(k8 + 7) * 65 + r]);
        *(v4u*)(p.out + (size_t)(p.r0 + r) * p.K + p.k0 + k8) = o; } }
    __syncthreads();
}

__global__ void __launch_bounds__(NWAVES * 64, 2) mk_fwd(Args args) {
    extern __shared__ __attribute__((aligned(16))) unsigned char lds_raw[];
    LAS unsigned char* lds = (LAS unsigned char*)lds_raw;
    constexpr int GA = 256, G = 128;
    gu32* ctl = (gu32*)(args.ws + WS_CTL);
    for (int u = threadIdx.x; u < (LDS_BYTES - LDSCTL_OFF) / 4; u += NWAVES * 64) ((LAS unsigned*)(lds + LDSCTL_OFF))[u] = 0u;
    __syncthreads();
    const int hs = (int)(blockIdx.x & 1);
    XcdBarrier bar_all = xcd_barrier_post((unsigned*)(ctl + CW_BAR), (volatile LAS unsigned*)(lds + MISC_OFF) + 8, 256u);
    XcdBarrier bar = xcd_barrier_post((unsigned*)(ctl + CW_BAR) + (1 + hs) * XCD_BAR_WORDS, (volatile LAS unsigned*)(lds + MISC_OFF) + 10, 128u);

    int prep_ = 0; (void)prep_;
    for (int ph = args.ph_lo; ph < args.ph_hi; ) {
        int tid = threadIdx.x; asm volatile("" : "+v"(tid));
        const int lane = tid & 63, wave = __builtin_amdgcn_readfirstlane(tid >> 6);
        int bx = blockIdx.x; asm volatile("" : "+s"(bx));
        int zi = 0; asm volatile("" : "+s"(zi));
        unsigned char* ws = args.ws + zi;
    const float* x = args.in[0 + zi]; const float* ln1 = args.in[1 + zi]; const float* w_in = args.in[2 + zi]; const float* pool_w = args.in[3 + zi]; const float* pool_scale = args.in[4 + zi];
    const float* m_conv = args.in[5 + zi]; const float* m_b_i = args.in[6 + zi]; const float* m_b_f = args.in[7 + zi]; const float* m_norm_g = args.in[8 + zi]; const float* a_q_g = args.in[9 + zi];
    const float* a_k_g = args.in[10 + zi]; const float* w_out = args.in[11 + zi]; const float* ln2 = args.in[12 + zi]; const float* w_up = args.in[13 + zi]; const float* ffn_conv = args.in[14 + zi]; const float* w_down = args.in[15 + zi];
    float* X = args.out + zi;
    bf16* Win = (bf16*)(ws + WS_WIN); bf16* Wout = (bf16*)(ws + WS_WOUT); bf16* Wup = (bf16*)(ws + WS_WUP); bf16* Wdown = (bf16*)(ws + WS_WDOWN);
    bf16* XB = (bf16*)(ws + WS_XB); bf16* Z = (bf16*)(ws + WS_Z); bf16* HACT = Z; bf16* MIX = (bf16*)(ws + WS_MIX);
    float* GATES = (float*)(ws + WS_GATES); float* ROWSQ = (float*)(ws + WS_ROWSQ); float* KPART = (float*)(ws + WS_KPART);
    float* DLOC = (float*)(ws + WS_DLOC); bf16* CT = (bf16*)(ws + WS_CT); float* NLOC = (float*)(ws + WS_NLOC); float* NPREV = (float*)(ws + WS_NPREV); float* SCAL = (float*)(ws + WS_SCAL); float* MPREV = (float*)(ws + WS_MPREV);
    bf16* PWT = (bf16*)(ws + WS_PWT); unsigned* LIST = (unsigned*)(ws + WS_LIST); bf16* PARTO = (bf16*)(ws + WS_PARTO); float* PARTL = (float*)(ws + WS_PARTL); unsigned* SELCNT = (unsigned*)(ws + WS_CTL) + CW_SEL;
    const int h = bx & 1, rk = bx >> 1;
    const int vcu = (rk % 4) * (G / 4) + rk / 4;

        if (ph == 0) {
            constexpr int I_IN = (NIN / 64) * (DM / 64), I_OUT = (DM / 64) * (DM / 64), I_UP = (NUP / 64) * (DM / 64), I_DOWN = (DM / 64) * (DFF / 64), I_L = I_IN + I_OUT + I_UP + I_DOWN, NITEMS = DEPTH * I_L;
            const int half = tid >> 8, t256 = tid & 255; LAS float* tl = (LAS float*)(lds + RING_OFF) + half * (64 * 65);
            auto decode = [&](int it) { PItem p; p.on = it < NITEMS; const int l = p.on ? it / I_L : 0; int r = p.on ? it % I_L : 0;
                if (r < I_IN) { p.W = w_in + (size_t)l * DM * IN_W; p.gain = ln1 + l * DM; p.out = Win + (size_t)l * NIN * DM; p.K = DM; p.Norig = IN_W; p.r0 = 64 * (r / 16); p.k0 = 64 * (r % 16); p.mode = 0; return p; } r -= I_IN;
                if (r < I_OUT) { p.W = w_out + (size_t)l * DM * DM; p.gain = nullptr; p.out = Wout + (size_t)l * DM * DM; p.K = DM; p.Norig = DM; p.r0 = 64 * (r / 16); p.k0 = 64 * (r % 16); p.mode = 1; return p; } r -= I_OUT;
                if (r < I_UP) { p.W = w_up + (size_t)l * DM * NUP; p.gain = ln2 + l * DM; p.out = Wup + (size_t)l * NUP * DM; p.K = DM; p.Norig = NUP; p.r0 = 64 * (r / 16); p.k0 = 64 * (r % 16); p.mode = 2; return p; } r -= I_UP;
                p.W = w_down + (size_t)l * DFF * DM; p.gain = nullptr; p.out = Wdown + (size_t)l * DM * DFF; p.K = DFF; p.Norig = DM; p.r0 = 64 * (r / 44); p.k0 = 64 * (r % 44); p.mode = 1; return p; };
            auto convert = [&](int first, int last, int wg, int nwg) {
                PItem cur = decode(first + 2 * wg + half); if (first + 2 * wg + half >= last) cur.on = false; float v[16]; pw_load(cur, t256, v);
                for (int it0 = first; it0 < last; it0 += 2 * nwg) {
                    const int itn = it0 + 2 * nwg + 2 * wg + half; PItem nxt = decode(itn); if (itn >= last) nxt.on = false; float vn[16]; pw_load(nxt, t256, vn);
                    pw_store(cur, tl, t256, v); cur = nxt;
#pragma unroll
                    for (int i = 0; i < 16; ++i) v[i] = vn[i]; } };
            for (int i = bx * 512 + tid; i < DEPTH * 4 * 4096; i += GA * 512) { const int lg = i >> 12, o = (i >> 6) & 63, c = i & 63; PWT[i] = (bf16)f2bf(pool_w[(size_t)lg * 4096 + c * 64 + o]); }
            for (int row = bx * NWAVES + wave; row < M; row += 2 * GA * NWAVES) { f32x4 xv[2][4];
#pragma unroll
                for (int q = 0; q < 2; ++q)
#pragma unroll
                    for (int j = 0; j < 4; ++j) xv[q][j] = *(const f32x4*)(x + (size_t)(row + q * GA * NWAVES) * DM + 256 * j + 4 * lane);
#pragma unroll
                for (int q = 0; q < 2; ++q) { const size_t rw = row + q * GA * NWAVES; float s = 0.f;
#pragma unroll
                    for (int j = 0; j < 4; ++j) { const f32x4 v = xv[q][j];
                        s += v.x * v.x + v.y * v.y + v.z * v.z + v.w * v.w; uint2 o; o.x = pk2(v.x, v.y); o.y = pk2(v.z, v.w); *(uint2*)(XB + rw * DM + 256 * j + 4 * lane) = o; }
                    s = wave_sum(s); if (lane < 4) ROWSQ[rw * 4 + lane] = lane == 0 ? s : 0.f; } }
            for (int pass = 0; pass < 2; ++pass) {
                if (pass == 1) { XcdBarrier bl = bar_all; bl.bar += zi; xcd_barrier(bl); if (h == 0) break; }
                convert(pass ? I_L : 0, pass ? NITEMS : I_L, pass ? rk : bx, pass ? G : GA);
                if (pass == 1) { asm volatile("s_waitcnt vmcnt(0)" ::: "memory"); __syncthreads();
                    if (tid == 0) { __builtin_amdgcn_fence(__ATOMIC_RELEASE, "agent"); asm volatile("s_waitcnt vmcnt(0)" ::: "memory"); __hip_atomic_fetch_add((unsigned*)(ctl + CW_CONV), 1u, __ATOMIC_RELAXED, __HIP_MEMORY_SCOPE_AGENT); } } }
        } else {
            const int l = (ph - 1) / 7, kind = (ph - 1) % 7;
            if (ph == 8) {
                if (tid == 0) { unsigned sp = 0; while (__hip_atomic_load((unsigned*)(ctl + CW_CONV), __ATOMIC_RELAXED, __HIP_MEMORY_SCOPE_AGENT) < 128u && ++sp < (1u << 22)) __builtin_amdgcn_s_sleep(8);
                    __builtin_amdgcn_fence(__ATOMIC_ACQUIRE, "agent"); asm volatile("s_waitcnt vmcnt(0)" ::: "memory"); }
                __syncthreads(); }
            {
            if (kind == PK_IN && !SKIP_PK_IN) {
                pg8::Gemm g{XB, Win + (size_t)l * NIN * DM, M, NIN, DM}; pg8::StaticOrder S; S.init(32, NIN / 256, G, rk, 4, 32 * h);
                pg8::EpiIn E{Z, GATES, KPART, ROWSQ, a_q_g + 64 * l, a_k_g + 64 * l, m_b_i + 4 * l, m_b_f + 4 * l};
                pg8::gemm_phase<pg8::EpiIn, pg8::StaticOrder, true, true>(lds + RING_OFF, g, S, E, tid);
            } else if (kind == PK_MIX1) {
                const int uA = vcu, uB = 247 - vcu, hA = uA / 31, hB = uB / 31; moba::SelKeep oA{0u, 0u}, oB{0u, 0u};
                if (vcu < 124) moba::sel_front(oA, oB, h, hA, 1 + (uA - 31 * hA), hB, 1 + (uB - 31 * hB), Z, KPART, SELCNT + l * 512, lds + RING_OFF, tid);
                int tidb = tid; asm volatile("" : "+v"(tidb));
                for (int u = vcu; u < 256; u += G) mlx::unit_a(4 * h + (u >> 6), u & 63, l, Z, GATES, m_conv + (size_t)l * 4 * 512, DLOC, NLOC, SCAL, lds + RING_OFF, tidb);
                asm volatile("" : "+v"(tidb));
                for (int u = vcu; u < 128; u += G) poolx::unit(128 * h + u, Z, PWT + (size_t)l * 4 * 4096, pool_scale + 256 * l, MIX, lds + RING_OFF, tidb);
                asm volatile("" : "+v"(tidb));
                if (vcu < 124) moba::sel_back(oA, oB, h, hA, 1 + (uA - 31 * hA), hB, 1 + (uB - 31 * hB), LIST, lds + RING_OFF, tidb);
            } else if (kind == PK_ATT) {
                for (int v = vcu; v < 128; v += G) mlx::unit_b(128 * h + v, DLOC, NLOC, SCAL, CT, NPREV, MPREV, (LAS float*)(lds + RING_OFF + 120 * 1024), tid);
                LAS unsigned* pre = (LAS unsigned*)(lds + RING_OFF + 124 * 1024);
                { unsigned inc = 0u; if (tid < 256) { const unsigned c = SELCNT[l * 512 + 256 * h + tid]; inc = (c + 255u) >> 8; }
#pragma unroll
                  for (int o = 1; o < 64; o <<= 1) { const unsigned v = __shfl_up(inc, o); if (lane >= o) inc += v; }
                  if (lane == 63) pre[520 + wave] = inc;
                  __syncthreads();
                  unsigned woff = 0u; for (int w = 0; w < wave; ++w) woff += pre[520 + w];
                  if (tid < 256) pre[1 + tid] = inc + woff; if (tid == 0) pre[0] = 0u;
                  __syncthreads(); }
                const int total = (int)pre[256];
                moba::sparse_stream(vcu, G, total, h, pre, SELCNT + l * 512, Z, LIST, PARTO, PARTL, lds + RING_OFF, tid);
            } else if (kind == PK_MLC) {
                for (int p = vcu; p < 256; p += G) moba::own_unit(h, p >> 5, p & 31, Z, PARTO, PARTL, MIX, lds + RING_OFF, tid);
                for (int u = vcu; u < 256; u += G) mlx::unit_c(4 * h + (u >> 6), u & 63, l, Z, GATES, m_conv + (size_t)l * 4 * 512, m_norm_g + 256 * l, CT, NPREV, MPREV, MIX, lds + RING_OFF, tid);
            } else if (kind == PK_OUT || kind == PK_DOWN) {
                const bool dn = kind == PK_DOWN;
                pg8::Gemm g{dn ? HACT : MIX, dn ? Wdown + (size_t)l * DM * DFF : Wout + (size_t)l * DM * DM, M, DM, dn ? DFF : DM}; pg8::StaticOrder S; S.init(32, DM / 256, G, rk, 4, 32 * h);
                pg8::EpiRes E{XB, ROWSQ, nullptr};
                pg8::gemm_phase<pg8::EpiRes, pg8::StaticOrder, true, true>(lds + RING_OFF, g, S, E, tid);
                if (dn && l == DEPTH - 1) {
                    asm volatile("s_waitcnt vmcnt(0)" ::: "memory"); __syncthreads(); __builtin_amdgcn_fence(__ATOMIC_ACQUIRE, "agent");
                    pg8::Unit u0; S.next(0, u0);
#pragma unroll 4
                    for (int it = tid; it < 256 * 32; it += 512) { const size_t eo = (size_t)(u0.pm * 256 + (it >> 5)) * DM + u0.pn * 256 + (it & 31) * 8; const v4u w = *(const v4u*)(XB + eo);
                        *(f32x4*)(X + eo) = (f32x4){bf2f(w.x), bf2f(w.x >> 16), bf2f(w.y), bf2f(w.y >> 16)}; *(f32x4*)(X + eo + 4) = (f32x4){bf2f(w.z), bf2f(w.z >> 16), bf2f(w.w), bf2f(w.w >> 16)}; } }
            } else if (kind == PK_UP && !SKIP_PK_UP) {
                pg8::Gemm g{XB, Wup + (size_t)l * NUP * DM, M, NUP, DM}; pg8::UpOrder S; S.init(33, NUP / 256, G, rk, 4, 33 * h);
                pg8::EpiUp E{HACT, ROWSQ, ffn_conv + (size_t)l * 3 * NUP, (bf16*)(ws + WS_CTL + 512 * 1024)};
                pg8::gemm_phase<pg8::EpiUp, pg8::UpOrder, true, true>(lds + RING_OFF, g, S, E, tid);
            }
            }
        }
        if (ph == 0) {}
        else if (ph + 1 < args.ph_hi) { XcdBarrier bl = bar; bl.bar += zi; xcd_barrier(bl); }
        ++ph;
    }
}

extern "C" void kernel_launch(void* const* d_in, const int* in_sizes, int n_in, void* d_out, int out_size, void* d_ws, size_t ws_size, hipStream_t stream) {
    if (n_in != 16 || out_size != M * DM || ws_size < WS_END) { fprintf(stderr, "kernel_launch: unexpected shapes (n_in %d out %d ws %zu)\n", n_in, out_size, ws_size); return; }
    static int ready = 0;
    if (!ready) { int dev = 0, cus = 0; (void)hipGetDevice(&dev); (void)hipDeviceGetAttribute(&cus, hipDeviceAttributeMultiprocessorCount, dev);
        if (cus != 256) fprintf(stderr, "kernel_launch: built for a 256-CU device (one 512-thread workgroup per CU), found %d\n", cus);
        if (hipFuncSetAttribute((const void*)mk_fwd, hipFuncAttributeMaxDynamicSharedMemorySize, LDS_BYTES) != hipSuccess) { fprintf(stderr, "kernel_launch: hipFuncSetAttribute failed\n"); return; } ready = 1; }
    (void)hipMemsetAsync((unsigned char*)d_ws + WS_CTL, 0, CTL_ZERO_BYTES, stream);
    Args a{}; for (int i = 0; i < 16; ++i) a.in[i] = (const float*)d_in[i]; a.out = (float*)d_out; a.ws = (unsigned char*)d_ws;
#ifdef MULTI_LAUNCH
    for (int ph = 0; ph < N_PHASES; ++ph) { a.ph_lo = ph; a.ph_hi = ph + 1; hipLaunchKernelGGL(mk_fwd, dim3(256), dim3(NWAVES * 64), LDS_BYTES, stream, a); }
#else
    a.ph_lo = 0; a.ph_hi = N_PHASES; hipLaunchKernelGGL(mk_fwd, dim3(256), dim3(NWAVES * 64), LDS_BYTES, stream, a);
#endif
}
```

```cpp
#include <hip/hip_runtime.h>
#include <cstdint>
#include <cstdio>

typedef unsigned short bf16;
typedef unsigned v4u __attribute__((ext_vector_type(4)));
typedef float f32x4 __attribute__((ext_vector_type(4)));

constexpr int BATCH = 2, SEQ = 8192, DM = 1024, DEPTH = 4, M = BATCH * SEQ;
constexpr int IN_W = 2824, NIN = 3072, ZP = 2816, DFF = 2816, NUP = 5632;
constexpr float EPS = 1e-6f;
constexpr float C2 = 0.125f * 1.4426950408889634f;
constexpr int ZC_AQ = 0, ZC_AK = 512, ZC_AV = 1024, ZC_POOL = 1536, ZC_MQ = 1792, ZC_MK = 2048, ZC_MV = 2304, ZC_MO = 2560, ZC_GATE = 2816;
constexpr int MC_POOL = 0, MC_ML = 256, MC_AT = 512;

constexpr size_t MiB = 1u << 20;
constexpr size_t WS_CTL = 0;
constexpr size_t WS_WIN = 1 * MiB;
constexpr size_t WS_WOUT = 25 * MiB;
constexpr size_t WS_WUP = 33 * MiB;
constexpr size_t WS_WDOWN = 77 * MiB;
constexpr size_t WS_XB = 99 * MiB;
constexpr size_t WS_Z = 131 * MiB;
constexpr size_t WS_MIX = 219 * MiB;
constexpr size_t WS_GATES = 251 * MiB;
constexpr size_t WS_ROWSQ = 252 * MiB;
constexpr size_t WS_KPART = 253 * MiB;
constexpr size_t WS_LIST = 254 * MiB;
constexpr size_t WS_DLOC = 270 * MiB;
constexpr size_t WS_CT = 278 * MiB;
constexpr size_t WS_NLOC = 282 * MiB;
constexpr size_t WS_NPREV = 283 * MiB;
constexpr size_t WS_SCAL = 284 * MiB;
constexpr size_t WS_MPREV = 284 * MiB + 65536;
constexpr size_t WS_PWT = 285 * MiB;
constexpr size_t WS_PARTO = 286 * MiB;
constexpr size_t WS_PARTL = 334 * MiB;
constexpr size_t WS_END = 336 * MiB;

typedef float hwf2_t __attribute__((ext_vector_type(2))); typedef __bf16 hwb2_t __attribute__((ext_vector_type(2)));
__host__ __device__ __forceinline__ unsigned f2bf(float f) {
#if defined(__HIP_DEVICE_COMPILE__)
    hwf2_t v = {f, 0.f}; return __builtin_bit_cast(unsigned, __builtin_convertvector(v, hwb2_t)) & 0xffffu;
#else
    unsigned u = __builtin_bit_cast(unsigned, f); return (u + 0x7fffu + ((u >> 16) & 1u)) >> 16;
#endif
}
__device__ __forceinline__ float bf2f(unsigned b) { return __builtin_bit_cast(float, (b & 0xffffu) << 16); }
__device__ __forceinline__ unsigned pk2(float lo, float hi) { hwf2_t v = {lo, hi}; return __builtin_bit_cast(unsigned, __builtin_convertvector(v, hwb2_t)); }
__device__ __forceinline__ float sigmoidf_(float x) { return 1.f / (1.f + __expf(-x)); }
__device__ __forceinline__ float siluf_(float x) { return x / (1.f + __expf(-x)); }
__device__ __forceinline__ float wave_sum(float v) {
#pragma unroll
    for (int o = 1; o < 64; o <<= 1) v += __shfl_xor(v, o);
    return v;
}
__device__ __forceinline__ float wave_max(float v) {
#pragma unroll
    for (int o = 1; o < 64; o <<= 1) v = fmaxf(v, __shfl_xor(v, o));
    return v;
}

__host__ __device__ __forceinline__ int in_orig_col(int zc) { return zc < 1536 ? 1288 + zc : (zc < 2816 ? zc - 1536 : (zc < 2824 ? 1280 + (zc - 2816) : -1)); }
__host__ __device__ __forceinline__ int in_row_to_zc(int r) { const int pn = r >> 8, s = r & 255; return 256 * pn + 64 * ((s >> 5) & 3) + 32 * (s >> 7) + (s & 31); }
__host__ __device__ __forceinline__ int up_row_to_orig(int r) { const int pn = r >> 8, s = r & 255; return (s >> 7) * DFF + 128 * pn + (s & 127); }

namespace pg8 {
#define PG8_LAS __attribute__((address_space(3)))
typedef unsigned short bf16_t;
typedef short bf16x8 __attribute__((ext_vector_type(8)));
typedef float f32x4 __attribute__((ext_vector_type(4)));
typedef unsigned u32x4 __attribute__((ext_vector_type(4)));
constexpr int BM = 256, BK = 64, HALF = 128, HTB = HALF * BK * 2  , STAGE_BYTES = 8 * HTB, NXCD = 8, WGM = 8;

__host__ __device__ __forceinline__ int lds_byte(int r, int c) { const int st = (r >> 4) * 2 + (c >> 5), rr = r & 15, cc = c & 31, ob = rr * 64 + cc * 2; return st * 1024 + (ob ^ (((ob >> 9) & 1) << 5)); }
__host__ __device__ __forceinline__ void stage_rc(int b, int& R, int& C) { const int st = b / 1024, sb = b % 1024, swz = sb ^ (((sb >> 9) & 1) << 5); R = (st >> 1) * 16 + swz / 64; C = (st & 1) * 32 + (swz % 64) / 2; }
__host__ __device__ __forceinline__ int perm32(int rho) { const int n = rho >> 4, i = rho & 15; return 8 * (i >> 2) + 4 * n + (i & 3); }

struct Unit { int pm, pn, arow; };
struct Gemm { const bf16_t* A; const bf16_t* Bt; int M, N, K; };

struct StaticOrder {
    int nM, nN, nwg, G, c, nx, pm0;
    __host__ __device__ void init(int nM_, int nN_, int G_, int c_, int nx_, int pm0_) { nM = nM_; nN = nN_; nwg = nM * nN; G = G_; c = c_; nx = nx_; pm0 = pm0_; }
    __host__ __device__ bool next(int i, Unit& u) const {
        const long L = (long)i * G + c; if (L >= nwg) return false;
        int wgid = (int)L; { const int q = nwg / nx, r = nwg % nx, xcd = wgid % nx, off = wgid / nx; wgid = (xcd < r ? xcd * (q + 1) : r * (q + 1) + (xcd - r) * q) + off; }
        const int nig = WGM * nN, gid = wgid / nig, fm = gid * WGM, gsz = (nM - fm) < WGM ? (nM - fm) : WGM;
        u.pm = pm0 + fm + ((wgid % nig) % gsz); u.pn = (wgid % nig) / gsz; u.arow = u.pm * BM; return true;
    }
    __device__ __forceinline__ void a_ready(const Unit&) const {}
    __device__ __forceinline__ void done(const Unit&) const {}
};


template <class Epi, class Sched, bool ALIGN_EPI = false, bool SP2 = false>
__device__ __forceinline__ void gemm_phase(PG8_LAS unsigned char* lds, const Gemm g, const Sched& S, const Epi& E, const int tid) {
    const int wid = __builtin_amdgcn_readfirstlane(tid >> 6), lane = tid & 63, wr = wid >> 2, wc = wid & 3, fr = lane & 15, fq = lane >> 4;
    const int K = g.K, nt = K / BK;
    unsigned voffA[2], voffB[2];
#pragma unroll
    for (int i = 0; i < 2; ++i) { int R, C; stage_rc(tid * 16 + i * 8192, R, C); const int Rb = Epi::PERM ? ((R & ~31) + perm32(R & 31)) : R;
        voffA[i] = (unsigned)(R * K + C) * 2u; voffB[i] = (unsigned)(Rb * K + C) * 2u; }
    const size_t kstep = (size_t)(BK * 2);
    const size_t hstep = (size_t)HALF * K * 2;
    const size_t tstep = 2 * hstep;
    const unsigned ldsw = (unsigned)wid * 1024u;
    const int aoff = lds_byte(wr * 64 + fr, fq * 8), boff = lds_byte(wc * 32 + fr, fq * 8);
#define PG8_SA(b, h) (((b) * 2 + (h)) * HTB)
#define PG8_SB(b, h) ((4 + (b) * 2 + (h)) * HTB)
#define PG8_STAGE(bufoff, gbase, voff) do { _Pragma("unroll") for (int _i = 0; _i < 2; ++_i) \
        __builtin_amdgcn_global_load_lds((const unsigned*)((const char*)(gbase) + (voff)[_i]), (PG8_LAS unsigned*)(lds + (bufoff) + ldsw + _i * 8192), 16, 0, 0); } while (0)
#define PG8_LDA(dst, b, h) do { _Pragma("unroll") for (int m = 0; m < 4; ++m) _Pragma("unroll") for (int k = 0; k < 2; ++k) dst[m][k] = *(const PG8_LAS bf16x8*)(lds + PG8_SA(b, h) + aoff + m * 2048 + k * 1024); } while (0)
#define PG8_LDB(dst, b, h) do { _Pragma("unroll") for (int n = 0; n < 2; ++n) _Pragma("unroll") for (int k = 0; k < 2; ++k) dst[n][k] = *(const PG8_LAS bf16x8*)(lds + PG8_SB(b, h) + boff + n * 2048 + k * 1024); } while (0)
#define PG8_MMA(ai, bj, At, Bt) do { __builtin_amdgcn_s_setprio(1); _Pragma("unroll") for (int m = 0; m < 4; ++m) _Pragma("unroll") for (int n = 0; n < 2; ++n) _Pragma("unroll") for (int k = 0; k < 2; ++k) \
        acc[ai][bj][m][n] = __builtin_amdgcn_mfma_f32_16x16x32_bf16(Bt[n][k], At[m][k], acc[ai][bj][m][n], 0, 0, 0); __builtin_amdgcn_s_setprio(0); } while (0)
#define PG8_WAIT_V(n) asm volatile("s_waitcnt vmcnt(" #n ")" ::: "memory")
#define PG8_WAIT_L(n) asm volatile("s_waitcnt lgkmcnt(" #n ")" ::: "memory")
#define PG8_BAR __builtin_amdgcn_s_barrier()
#define PG8_SCHED __builtin_amdgcn_sched_barrier(0)
    Unit cur, nxt; int ui = 0;
    if (!S.next(0, cur)) return;
    f32x4 acc[2][2][4][2];
#pragma unroll
    for (int a = 0; a < 2; ++a)
#pragma unroll
        for (int b = 0; b < 2; ++b)
#pragma unroll
            for (int m = 0; m < 4; ++m)
#pragma unroll
                for (int n = 0; n < 2; ++n) acc[a][b][m][n] = (f32x4){0.f, 0.f, 0.f, 0.f};
    bf16x8 At[4][2], B0[2][2], B1[2][2];
    const char* cA = (const char*)g.A + (ptrdiff_t)cur.arow * (ptrdiff_t)(K * 2); const char* cB = (const char*)g.Bt + (size_t)cur.pn * tstep;
    S.a_ready(cur);
    if constexpr (SP2) {
        PG8_STAGE(PG8_SB(0, 0), cB, voffB); PG8_STAGE(PG8_SB(0, 1), cB + hstep, voffB); PG8_STAGE(PG8_SA(0, 0), cA, voffA); PG8_STAGE(PG8_SA(0, 1), cA + hstep, voffA);
        if (wr == 1) PG8_BAR;
        PG8_WAIT_V(2); PG8_BAR;
        PG8_STAGE(PG8_SB(1, 0), cB + kstep, voffB); PG8_STAGE(PG8_SA(1, 0), cA + kstep, voffA); PG8_STAGE(PG8_SB(1, 1), cB + hstep + kstep, voffB);
        PG8_WAIT_V(6); PG8_BAR;
    } else {
        PG8_STAGE(PG8_SB(0, 0), cB, voffB); PG8_STAGE(PG8_SA(0, 0), cA, voffA); PG8_STAGE(PG8_SB(0, 1), cB + hstep, voffB); PG8_STAGE(PG8_SA(0, 1), cA + hstep, voffA);
        if (wr == 1) PG8_BAR;
        PG8_WAIT_V(4); PG8_BAR;
        PG8_STAGE(PG8_SB(1, 0), cB + kstep, voffB); PG8_STAGE(PG8_SA(1, 0), cA + kstep, voffA); PG8_STAGE(PG8_SB(1, 1), cB + hstep + kstep, voffB);
        PG8_WAIT_V(6); PG8_BAR;
    }
    for (;;) {
        const bool has_next = S.next(ui + 1, nxt);
        const char* nA = has_next ? (const char*)g.A + (ptrdiff_t)nxt.arow * (ptrdiff_t)(K * 2) : cA + (size_t)(nt - 2) * kstep; const char* nB = has_next ? (const char*)g.Bt + (size_t)nxt.pn * tstep : cB + (size_t)(nt - 2) * kstep;
        for (int t = 0; t < nt; t += 2) {
            const bool last = (t == nt - 2);
            const char* a1 = cA + (size_t)(t + 1) * kstep;
            const char* a2 = last ? nA : cA + (size_t)(t + 2) * kstep; const char* b2 = last ? nB : cB + (size_t)(t + 2) * kstep;
            const char* a3 = a2 + kstep; const char* b3 = b2 + kstep;
            if (last && has_next) S.a_ready(nxt);
            if constexpr (SP2) {
            PG8_LDB(B0, 0, 0); PG8_LDB(B1, 0, 1); PG8_SCHED; PG8_LDA(At, 0, 0); PG8_STAGE(PG8_SA(1, 1), a1 + hstep, voffA);
            PG8_WAIT_V(8); PG8_WAIT_L(0); PG8_BAR; PG8_MMA(0, 0, At, B0); PG8_MMA(0, 1, At, B1); PG8_BAR; PG8_SCHED;
            PG8_LDA(At, 0, 1); PG8_STAGE(PG8_SB(0, 0), b2, voffB); PG8_STAGE(PG8_SB(0, 1), b2 + hstep, voffB); PG8_STAGE(PG8_SA(0, 0), a2, voffA);
            PG8_WAIT_V(8); PG8_WAIT_L(0); PG8_BAR; PG8_MMA(1, 0, At, B0); PG8_MMA(1, 1, At, B1); PG8_BAR; PG8_SCHED;
            PG8_LDB(B0, 1, 0); PG8_LDB(B1, 1, 1); PG8_SCHED; PG8_LDA(At, 1, 0); PG8_STAGE(PG8_SA(0, 1), a2 + hstep, voffA);
            PG8_WAIT_V(8); PG8_WAIT_L(0); PG8_BAR; PG8_MMA(0, 0, At, B0); PG8_MMA(0, 1, At, B1); PG8_BAR; PG8_SCHED;
            PG8_LDA(At, 1, 1); PG8_STAGE(PG8_SB(1, 0), b3, voffB); PG8_STAGE(PG8_SB(1, 1), b3 + hstep, voffB); PG8_STAGE(PG8_SA(1, 0), a3, voffA);
            PG8_WAIT_V(8); PG8_WAIT_L(0); PG8_BAR; PG8_MMA(1, 0, At, B0); PG8_MMA(1, 1, At, B1); PG8_BAR; PG8_SCHED;
            } else {
            PG8_LDB(B0, 0, 0); PG8_SCHED; PG8_LDA(At, 0, 0); PG8_STAGE(PG8_SA(1, 1), a1 + hstep, voffA);
            PG8_WAIT_L(8); PG8_BAR; PG8_WAIT_L(0); PG8_MMA(0, 0, At, B0); PG8_BAR; PG8_SCHED;
            PG8_LDB(B1, 0, 1); PG8_STAGE(PG8_SB(0, 0), b2, voffB);
            PG8_BAR; PG8_WAIT_L(0); PG8_MMA(0, 1, At, B1); PG8_BAR;
            PG8_LDA(At, 0, 1); PG8_STAGE(PG8_SA(0, 0), a2, voffA);
            PG8_BAR; PG8_WAIT_L(0); PG8_MMA(1, 0, At, B0); PG8_BAR; PG8_SCHED;
            PG8_STAGE(PG8_SB(0, 1), b2 + hstep, voffB);
            PG8_WAIT_V(6); PG8_BAR; PG8_MMA(1, 1, At, B1); PG8_BAR;
            PG8_LDB(B0, 1, 0); PG8_SCHED; PG8_LDA(At, 1, 0); PG8_STAGE(PG8_SA(0, 1), a2 + hstep, voffA);
            PG8_WAIT_L(8); PG8_BAR; PG8_WAIT_L(0); PG8_MMA(0, 0, At, B0); PG8_BAR; PG8_SCHED;
            PG8_LDB(B1, 1, 1); PG8_STAGE(PG8_SB(1, 0), b3, voffB);
            PG8_BAR; PG8_WAIT_L(0); PG8_MMA(0, 1, At, B1); PG8_BAR;
            PG8_LDA(At, 1, 1); PG8_STAGE(PG8_SA(1, 0), a3, voffA);
            PG8_BAR; PG8_WAIT_L(0); PG8_MMA(1, 0, At, B0); PG8_BAR; PG8_SCHED;
            PG8_STAGE(PG8_SB(1, 1), b3 + hstep, voffB);
            PG8_WAIT_V(6); PG8_BAR; PG8_MMA(1, 1, At, B1); PG8_BAR;
            }
        }
        if constexpr (ALIGN_EPI) { if (wr == 0) PG8_BAR; }
        if constexpr (!Epi::AFTER_DRAIN) { E(acc, cur, wr, wc, fr, fq, lds, ui, has_next ? nxt.pn : -1); S.done(cur); }
        if (!has_next) break;
#pragma unroll
        for (int a = 0; a < 2; ++a)
#pragma unroll
            for (int b = 0; b < 2; ++b)
#pragma unroll
                for (int m = 0; m < 4; ++m)
#pragma unroll
                    for (int n = 0; n < 2; ++n) acc[a][b][m][n] = (f32x4){0.f, 0.f, 0.f, 0.f};
        cur = nxt; cA = nA; cB = nB; ++ui;
        if constexpr (ALIGN_EPI) { if (wr == 1) PG8_BAR; }
    }
    PG8_WAIT_V(0);
    if constexpr (!ALIGN_EPI) { if (wr == 0) PG8_BAR; }
    PG8_BAR;
    if constexpr (Epi::AFTER_DRAIN) { E.fused(acc, cur, wr, wc, fr, fq, lds, wid, lane); S.done(cur); }
#undef PG8_SA
#undef PG8_SB
#undef PG8_STAGE
#undef PG8_LDA
#undef PG8_LDB
#undef PG8_MMA
#undef PG8_WAIT_V
#undef PG8_WAIT_L
#undef PG8_BAR
#undef PG8_SCHED
}
}

namespace pg8 {
typedef float f32x2_t __attribute__((ext_vector_type(2))); typedef __bf16 bf16x2_t __attribute__((ext_vector_type(2)));
__device__ __forceinline__ unsigned cvtpk(float lo, float hi) { f32x2_t v = {lo, hi}; bf16x2_t b = __builtin_convertvector(v, bf16x2_t); return __builtin_bit_cast(unsigned, b); }
__device__ __forceinline__ u32x4 pack8(const f32x4 a, const f32x4 b) { u32x4 w; w.x = cvtpk(a.x, a.y); w.y = cvtpk(a.z, a.w); w.z = cvtpk(b.x, b.y); w.w = cvtpk(b.z, b.w); return w; }
__device__ __forceinline__ float dot4(const f32x4 a) { return (a.x * a.x + a.y * a.y) + (a.z * a.z + a.w * a.w); }
__device__ __forceinline__ float rstd_of(const f32x4 a) { return __builtin_amdgcn_rsqf(((a.x + a.y) + (a.z + a.w)) * (1.f / 1024.f) + 1e-6f); }
__device__ __forceinline__ float fsigmoid(float x) { return __builtin_amdgcn_rcpf(1.f + __builtin_amdgcn_exp2f(-1.4426950408889634f * x)); }
template <int CTRL> __device__ __forceinline__ float dpp_rot(float src) { return __builtin_bit_cast(float, __builtin_amdgcn_update_dpp(__builtin_bit_cast(int, src), __builtin_bit_cast(int, src), CTRL, 0xf, 0xf, true)); }
__device__ __forceinline__ float rowsum16(float s) { s += dpp_rot<0xB1>(s); s += dpp_rot<0x4E>(s); s += dpp_rot<0x141>(s); s += dpp_rot<0x140>(s); return s; }
template <int CTRL> __device__ __forceinline__ float dpp_mov(float old, float src) { return __builtin_bit_cast(float, __builtin_amdgcn_update_dpp(__builtin_bit_cast(int, old), __builtin_bit_cast(int, src), CTRL, 0xf, 0xf, false)); }

struct EpiIn {
    static constexpr bool PERM = true, AFTER_DRAIN = false;
    bf16_t* Z; float* gates; float* kpart; const float* rowsq; const float* gq; const float* gk; const float* b_i; const float* b_f;
    __device__ __forceinline__ void operator()(f32x4 (&acc)[2][2][4][2], const Unit& u, int wr, int wc, int fr, int fq, PG8_LAS unsigned char* lds, int ui, int) const {
        const int row0 = u.pm * BM + wr * 64 + fr, pn = u.pn;
        float rs[2][4];
        f32x4 gv[2][2];
        PG8_LAS float* rsl = (PG8_LAS float*)(lds + 131072 + 1024);
        const bool hit = ui > 0 && ((const PG8_LAS int*)rsl)[384] == u.pm;
        if (!hit) {
            { const float* gg = pn < 2 ? gq : gk;
#pragma unroll
              for (int bj = 0; bj < 2; ++bj)
#pragma unroll
                  for (int n = 0; n < 2; ++n) gv[bj][n] = *(const f32x4*)(gg + 32 * bj + 8 * fq + 4 * n); }
            f32x4 q[2][4];
#pragma unroll
            for (int ai = 0; ai < 2; ++ai)
#pragma unroll
                for (int m = 0; m < 4; ++m) q[ai][m] = *(const f32x4*)(rowsq + 4 * (size_t)(row0 + ai * HALF + m * 16));
#pragma unroll
            for (int ai = 0; ai < 2; ++ai)
#pragma unroll
                for (int m = 0; m < 4; ++m) rs[ai][m] = rstd_of(q[ai][m]);
            if (wc == 0 && fq == 0) {
#pragma unroll
                for (int ai = 0; ai < 2; ++ai)
#pragma unroll
                    for (int m = 0; m < 4; ++m) rsl[ai * HALF + wr * 64 + m * 16 + fr] = rs[ai][m]; }
            if (wr == 0 && wc == 0) { const int l = fq * 16 + fr; if (l < 32) *(PG8_LAS f32x4*)(rsl + 256 + 4 * l) = *(const f32x4*)((l < 16 ? gq : gk) + 4 * (l & 15)); if (l == 0) ((PG8_LAS int*)rsl)[384] = u.pm; }
        } else {
#pragma unroll
            for (int ai = 0; ai < 2; ++ai)
#pragma unroll
                for (int m = 0; m < 4; ++m) rs[ai][m] = rsl[ai * HALF + wr * 64 + m * 16 + fr];
#pragma unroll
            for (int bj = 0; bj < 2; ++bj)
#pragma unroll
                for (int n = 0; n < 2; ++n) gv[bj][n] = *(const PG8_LAS f32x4*)(rsl + 256 + (pn < 2 ? 0 : 64) + 32 * bj + 8 * fq + 4 * n);
        }
        const int zc0 = 256 * pn + 64 * wc + 8 * fq;
        if (pn < 4) {
            const float mul = pn < 2 ? C2 : 1.f;
            f32x4 ks[2][2];
#pragma unroll
            for (int bj = 0; bj < 2; ++bj)
#pragma unroll
                for (int n = 0; n < 2; ++n) { gv[bj][n] *= mul; ks[bj][n] = (f32x4){0.f, 0.f, 0.f, 0.f}; }
#pragma unroll
            for (int ai = 0; ai < 2; ++ai)
#pragma unroll
                for (int m = 0; m < 4; ++m) {
                    f32x4 v[2][2]; float ss = 0.f;
#pragma unroll
                    for (int bj = 0; bj < 2; ++bj)
#pragma unroll
                        for (int n = 0; n < 2; ++n) { v[bj][n] = acc[ai][bj][m][n] * rs[ai][m]; ss += dot4(v[bj][n]); }
                    ss += __shfl_xor(ss, 16); ss += __shfl_xor(ss, 32);
                    const float r = rsqrtf(ss * (1.f / 64.f) + 1e-6f);
                    bf16_t* rowp = Z + (size_t)(row0 + ai * HALF + m * 16) * ZP + zc0;
#pragma unroll
                    for (int bj = 0; bj < 2; ++bj) { const f32x4 o0 = v[bj][0] * r * gv[bj][0], o1 = v[bj][1] * r * gv[bj][1]; ks[bj][0] += o0; ks[bj][1] += o1; *(u32x4*)(rowp + 32 * bj) = pack8(o0, o1); }
                }
            if (pn >= 2) {
#pragma unroll
                for (int bj = 0; bj < 2; ++bj)
#pragma unroll
                    for (int n = 0; n < 2; ++n)
#pragma unroll
                        for (int e = 0; e < 4; ++e) { ks[bj][n][e] = rowsum16(ks[bj][n][e]); }
                if (fr == 0) { const int bh = (u.pm >> 5) * 8 + (pn - 2) * 4 + wc, nb = u.pm & 31; float* kp = kpart + ((size_t)(bh * 32 + nb) * 2 + wr) * 64 + 8 * fq;
#pragma unroll
                    for (int bj = 0; bj < 2; ++bj)
#pragma unroll
                        for (int n = 0; n < 2; ++n) *(f32x4*)(kp + 32 * bj + 4 * n) = ks[bj][n]; }
            }
        } else if (pn < 11) {
#pragma unroll
            for (int ai = 0; ai < 2; ++ai)
#pragma unroll
                for (int m = 0; m < 4; ++m) { bf16_t* rowp = Z + (size_t)(row0 + ai * HALF + m * 16) * ZP + zc0;
#pragma unroll
                    for (int bj = 0; bj < 2; ++bj) { f32x4 v0 = acc[ai][bj][m][0] * rs[ai][m], v1 = acc[ai][bj][m][1] * rs[ai][m];
                        if (pn == 10) {
#pragma unroll
                            for (int e = 0; e < 4; ++e) { v0[e] = fsigmoid(v0[e]); v1[e] = fsigmoid(v1[e]); } }
                        *(u32x4*)(rowp + 32 * bj) = pack8(v0, v1); } }
        } else if (wc == 0 && fq == 0) {
            const f32x4 bi = *(const f32x4*)b_i, bf = *(const f32x4*)b_f;
#pragma unroll
            for (int ai = 0; ai < 2; ++ai)
#pragma unroll
                for (int m = 0; m < 4; ++m) { float* gp = gates + (size_t)(row0 + ai * HALF + m * 16) * 8;
                    *(f32x4*)gp = acc[ai][0][m][0] * rs[ai][m] + bi; *(f32x4*)(gp + 4) = acc[ai][0][m][1] * rs[ai][m] + bf; }
        }
    }
};
constexpr int EXCH_OFF = 131072 + 1024;
struct EpiRes {
    static constexpr bool PERM = true, AFTER_DRAIN = false;
    bf16_t* XB; float* rowsq; float* out;
    __device__ __forceinline__ void operator()(f32x4 (&acc)[2][2][4][2], const Unit& u, int wr, int wc, int fr, int fq, PG8_LAS unsigned char* lds, int, int) const {
        const int row0 = u.pm * BM + wr * 64 + fr, col0 = u.pn * BM + wc * 32 + 8 * fq;
        PG8_LAS float* rq = (PG8_LAS float*)(lds + EXCH_OFF);
        if (out) {
            asm volatile("" : "+v"(fr), "+v"(fq));
            const int row0 = u.pm * BM + wr * 64 + fr, col0 = u.pn * BM + wc * 32 + 8 * fq;
#pragma unroll
            for (int ai = 0; ai < 2; ++ai) {
                u32x4 xv[4][2];
#pragma unroll
                for (int m = 0; m < 4; ++m)
#pragma unroll
                    for (int bj = 0; bj < 2; ++bj) xv[m][bj] = *(const u32x4*)(XB + (size_t)(row0 + ai * HALF + m * 16) * DM + col0 + bj * HALF);
#pragma unroll
                for (int m = 0; m < 4; ++m) { const size_t row = row0 + ai * HALF + m * 16;
#pragma unroll
                    for (int bj = 0; bj < 2; ++bj) { const u32x4 w = xv[m][bj];
                        f32x4 x0 = (f32x4){__builtin_bit_cast(float, w.x << 16), __builtin_bit_cast(float, w.x & 0xffff0000u), __builtin_bit_cast(float, w.y << 16), __builtin_bit_cast(float, w.y & 0xffff0000u)};
                        f32x4 x1 = (f32x4){__builtin_bit_cast(float, w.z << 16), __builtin_bit_cast(float, w.z & 0xffff0000u), __builtin_bit_cast(float, w.w << 16), __builtin_bit_cast(float, w.w & 0xffff0000u)};
                        *(f32x4*)(out + row * DM + col0 + bj * HALF) = x0 + acc[ai][bj][m][0]; *(f32x4*)(out + row * DM + col0 + bj * HALF + 4) = x1 + acc[ai][bj][m][1]; } }
                asm volatile("" ::: "memory"); }
            return;
        }
        u32x4 xv[4][2];
#pragma unroll
        for (int m = 0; m < 4; ++m)
#pragma unroll
            for (int bj = 0; bj < 2; ++bj) xv[m][bj] = *(const u32x4*)(XB + (size_t)(row0 + m * 16) * DM + col0 + bj * HALF);
#pragma unroll
        for (int ai = 0; ai < 2; ++ai) {
#pragma unroll
            for (int m = 0; m < 4; ++m) { const size_t row = row0 + ai * HALF + m * 16; float ss = 0.f;
#pragma unroll
                for (int bj = 0; bj < 2; ++bj) { const u32x4 w = xv[m][bj];
                    f32x4 x0 = (f32x4){__builtin_bit_cast(float, w.x << 16), __builtin_bit_cast(float, w.x & 0xffff0000u), __builtin_bit_cast(float, w.y << 16), __builtin_bit_cast(float, w.y & 0xffff0000u)};
                    f32x4 x1 = (f32x4){__builtin_bit_cast(float, w.z << 16), __builtin_bit_cast(float, w.z & 0xffff0000u), __builtin_bit_cast(float, w.w << 16), __builtin_bit_cast(float, w.w & 0xffff0000u)};
                    x0 += acc[ai][bj][m][0]; x1 += acc[ai][bj][m][1];
                    ss += dot4(x0) + dot4(x1); *(u32x4*)(XB + row * DM + col0 + bj * HALF) = pack8(x0, x1);
                    if (ai == 0) xv[m][bj] = *(const u32x4*)(XB + (size_t)(row0 + HALF + m * 16) * DM + col0 + bj * HALF);
                    }
                ss += __shfl_xor(ss, 16); ss += __shfl_xor(ss, 32);
                if (fq == 0) rq[wc * 256 + ai * HALF + wr * 64 + m * 16 + fr] = ss; } }
        asm volatile("s_waitcnt lgkmcnt(0)" ::: "memory"); __builtin_amdgcn_s_barrier(); asm volatile("" ::: "memory");
        { const int r = (wr * 4 + wc) * 64 + fq * 16 + fr; if (r < 256) rowsq[(size_t)(u.pm * BM + r) * 4 + u.pn] = (rq[r] + rq[256 + r]) + (rq[512 + r] + rq[768 + r]); }
    }
};
struct EpiUp {
    static constexpr bool PERM = true, AFTER_DRAIN = false;
    bf16_t* hact; const float* rowsq; const float* fconv; bf16_t* trash;
    __device__ __forceinline__ void operator()(f32x4 (&acc)[2][2][4][2], const Unit& u, int wr, int wc, int fr, int fq, PG8_LAS unsigned char* lds, int ui, int npn) const {
        const int b = u.pm / 33, tb = u.pm - 33 * b, t0 = 254 * tb - 2, rbase = wr * 64 + fr;
        PG8_LAS float* exb = (PG8_LAS float*)(lds + EXCH_OFF);
        PG8_LAS float* rsl = exb + 2048 + 1536;
        const bool hit = ui > 0 && ((const PG8_LAS int*)rsl)[256] == u.pm;
        const int wt = ((wr * 4 + wc) * 4 + fq) * 16 + fr;
        f32x4 fw = (f32x4){0.f, 0.f, 0.f, 0.f}, fwn = fw;
        if (ui == 0 && wt < 192) { const int j = wt >> 6, bj = (wt >> 5) & 1, c4 = (wt & 31) * 4; fw = *(const f32x4*)(fconv + j * NUP + bj * DFF + 128 * u.pn + c4); }
        if (npn >= 0 && wt < 192) { const int j = wt >> 6, bj = (wt >> 5) & 1, c4 = (wt & 31) * 4; fwn = *(const f32x4*)(fconv + j * NUP + bj * DFF + 128 * npn + c4); }
        float rsv[2][4];
        if (!hit) {
            const float* rq0 = rowsq + 4 * ((ptrdiff_t)b * SEQ + t0 + rbase);
            f32x4 q[2][4];
#pragma unroll
            for (int ai = 0; ai < 2; ++ai)
#pragma unroll
                for (int m = 0; m < 4; ++m) q[ai][m] = *(const f32x4*)(rq0 + 4 * (ai * HALF + m * 16));
#pragma unroll
            for (int ai = 0; ai < 2; ++ai)
#pragma unroll
                for (int m = 0; m < 4; ++m) { const int t = t0 + ai * HALF + m * 16 + rbase; rsv[ai][m] = (t >= 0 && t < SEQ) ? rstd_of(q[ai][m]) : 0.f; }
            if (wc == 0 && fq == 0) {
#pragma unroll
                for (int ai = 0; ai < 2; ++ai)
#pragma unroll
                    for (int m = 0; m < 4; ++m) rsl[ai * HALF + m * 16 + rbase] = rsv[ai][m]; }
            if (wt == 0) ((PG8_LAS int*)rsl)[256] = u.pm;
        } else {
#pragma unroll
            for (int ai = 0; ai < 2; ++ai)
#pragma unroll
                for (int m = 0; m < 4; ++m) rsv[ai][m] = rsl[ai * HALF + m * 16 + rbase];
        }
#pragma unroll
        for (int ai = 0; ai < 2; ++ai) {
#pragma unroll
            for (int m = 0; m < 4; ++m) { const float rs = rsv[ai][m];
#pragma unroll
                for (int bj = 0; bj < 2; ++bj)
#pragma unroll
                    for (int n = 0; n < 2; ++n)
#pragma unroll
                        for (int e = 0; e < 4; ++e) acc[ai][bj][m][n][e] *= rs; } }
        PG8_LAS float* ex = (PG8_LAS float*)(lds + EXCH_OFF);
        if (fr >= 14) {
#pragma unroll
            for (int ai = 0; ai < 2; ++ai)
#pragma unroll
                for (int bj = 0; bj < 2; ++bj)
#pragma unroll
                    for (int n = 0; n < 2; ++n) *(PG8_LAS f32x4*)(ex + ((((ai * 2 + wr) * 4 + wc) * 2 + (fr - 14)) * 64 + 32 * bj + 8 * fq + 4 * n)) = acc[ai][bj][3][n]; }
        PG8_LAS float* wl = ex + 2048 + (ui & 1) * 768;
        if (ui == 0 && wt < 192) { const int j = wt >> 6, bj = (wt >> 5) & 1, c4 = (wt & 31) * 4; *(PG8_LAS f32x4*)(wl + (j * 2 + bj) * 128 + c4) = fw; }
        asm volatile("s_waitcnt lgkmcnt(0)" ::: "memory"); __builtin_amdgcn_s_barrier(); asm volatile("" ::: "memory");
        const int ch0 = 128 * u.pn + 32 * wc + 8 * fq;
#pragma unroll
        for (int ai = 0; ai < 2; ++ai) {
            const bool has_prev = !(ai == 0 && wr == 0); const int sai = wr ? ai : 0, swr = wr ? 0 : 1;
#pragma unroll
            for (int mm = 0; mm < 4; ++mm) { const int m = 3 - mm;
#pragma unroll
                for (int bj = 0; bj < 2; ++bj)
#pragma unroll
                    for (int n = 0; n < 2; ++n) {
                        const f32x4 cur = acc[ai][bj][m][n]; f32x4 c1, c2;
                        if (m > 0) { const f32x4 pv = acc[ai][bj][m - 1][n];
#pragma unroll
                            for (int e = 0; e < 4; ++e) { const float r1 = dpp_rot<0x121>(pv[e]), r2 = dpp_rot<0x122>(pv[e]); c1[e] = dpp_mov<0x111>(r1, cur[e]); c2[e] = dpp_mov<0x112>(r2, cur[e]); }
                        } else { f32x4 p14 = (f32x4){0.f, 0.f, 0.f, 0.f}, p15 = p14;
                            if (has_prev) { const PG8_LAS float* sp = ex + ((((sai * 2 + swr) * 4 + wc) * 2) * 64 + 32 * bj + 8 * fq + 4 * n); p14 = *(const PG8_LAS f32x4*)sp; p15 = *(const PG8_LAS f32x4*)(sp + 64); }
#pragma unroll
                            for (int e = 0; e < 4; ++e) { const float r1 = p15[e], r2 = fr == 0 ? p14[e] : p15[e]; c1[e] = dpp_mov<0x111>(r1, cur[e]); c2[e] = dpp_mov<0x112>(r2, cur[e]); } }
                        const PG8_LAS float* wp = wl + bj * 128 + 32 * wc + 8 * fq + 4 * n;
                        acc[ai][bj][m][n] = *(const PG8_LAS f32x4*)(wp + 512) * cur + *(const PG8_LAS f32x4*)(wp + 256) * c1 + *(const PG8_LAS f32x4*)wp * c2;
                    }
                const int r = ai * HALF + m * 16 + rbase, t = t0 + r;
                { f32x4 h0, h1;
#pragma unroll
                    for (int e = 0; e < 4; ++e) { const float g0 = acc[ai][0][m][0][e], g1 = acc[ai][0][m][1][e]; h0[e] = g0 * fsigmoid(g0) * acc[ai][1][m][0][e]; h1[e] = g1 * fsigmoid(g1) * acc[ai][1][m][1][e]; }
                    if (r >= 2 && t < SEQ) *(u32x4*)(hact + ((size_t)b * SEQ + t) * DFF + ch0) = pack8(h0, h1); }
            }
        }
        if (npn >= 0 && wt < 192) { const int j = wt >> 6, bj = (wt >> 5) & 1, c4 = (wt & 31) * 4; *(PG8_LAS f32x4*)(ex + 2048 + ((ui + 1) & 1) * 768 + (j * 2 + bj) * 128 + c4) = fwn; }
    }
};
struct UpOrder : StaticOrder {
    __device__ bool next(int i, Unit& u) const { if (!StaticOrder::next(i, u)) return false; const int b = u.pm / 33, tb = u.pm - 33 * b; u.arow = b * SEQ + 254 * tb - 2; return true; }
};
}

#define GAS __attribute__((address_space(1)))
#define LAS __attribute__((address_space(3)))
typedef unsigned short bf16;
typedef unsigned v4u __attribute__((ext_vector_type(4)));
typedef float f32x4 __attribute__((ext_vector_type(4)));
typedef short bf16x8 __attribute__((ext_vector_type(8)));
typedef GAS unsigned gu32;
typedef GAS unsigned long long gu64;
#define RLX_AGENT __ATOMIC_RELAXED, __HIP_MEMORY_SCOPE_AGENT
#define LDS_WAIT() asm volatile("s_waitcnt lgkmcnt(0)" ::: "memory")
#define VM_WAIT() asm volatile("s_waitcnt vmcnt(0)" ::: "memory")
__device__ __forceinline__ unsigned long long rt() { return __builtin_amdgcn_s_memrealtime(); }

#define XB_TMO      128
#define XB_XCNT(j)  (256  + 64 * (j))
#define XB_XSUB(j)  (1280 + 64 * (j))
#define XB_XGEN(j)  (2304 + 64 * (j))
#define XB_TOP      3328
#define XB_TOPGEN   3392
#define XCD_BAR_WORDS 3456
#define XB_SPIN_CAP (1u << 18)

__device__ __forceinline__ unsigned xb_ld(unsigned* p)              { return __hip_atomic_load(p, __ATOMIC_RELAXED, __HIP_MEMORY_SCOPE_AGENT); }
__device__ __forceinline__ unsigned xb_add(unsigned* p, unsigned v) { return __hip_atomic_fetch_add(p, v, __ATOMIC_RELAXED, __HIP_MEMORY_SCOPE_AGENT); }
__device__ __forceinline__ unsigned xb_xcc_id() { return (unsigned)__builtin_amdgcn_s_getreg((3 << 11) | 20) & 0xFu; }
#define XB_SPIN(cond, bar) do { unsigned _sp = 0; while (cond) { __builtin_amdgcn_s_sleep(1); \
    if ((++_sp & 255u) == 0u) { if (xb_ld(&(bar)[XB_TMO])) break; if (_sp > XB_SPIN_CAP) { atomicAdd(&(bar)[XB_TMO], 1u); break; } } } } while (0)

struct XcdBarrier {
    unsigned* bar; unsigned x; unsigned G;
    volatile LAS unsigned* st;
};

__device__ __forceinline__ XcdBarrier xcd_barrier_post(unsigned* bar, volatile LAS unsigned* st, unsigned G) {
    XcdBarrier b; b.bar = bar; b.x = xb_xcc_id(); b.st = st; b.G = G;
    if (threadIdx.x == 0) (void)xb_add(&bar[XB_XCNT(b.x)], 1u);
    return b;
}
__device__ __forceinline__ void xcd_barrier_complete(unsigned* bar, unsigned x, unsigned G, unsigned& nloc, unsigned& nx) {
    unsigned sum, cnt, mine, sp = 0u;
    for (;;) {
        sum = 0u; cnt = 0u; mine = 0u;
#pragma unroll
        for (unsigned j = 0; j < 16; ++j) { const unsigned c = xb_ld(&bar[XB_XCNT(j)]); sum += c; cnt += (c > 0u) ? 1u : 0u; mine = (j == x) ? c : mine; }
        if (sum == G) break;
        __builtin_amdgcn_s_sleep(1);
        if ((++sp & 255u) == 0u) { if (xb_ld(&bar[XB_TMO])) break; if (sp > XB_SPIN_CAP) { atomicAdd(&bar[XB_TMO], 1u); break; } }
    }
    nloc = mine > 0u ? mine : 1u; nx = cnt > 0u ? cnt : 1u;
}

__device__ __forceinline__ void xcd_barrier(const XcdBarrier& b) {
    asm volatile("s_waitcnt vmcnt(0)" ::: "memory");
    __syncthreads();
    if (threadIdx.x == 0) {
        unsigned* bar = b.bar;
        __builtin_amdgcn_s_waitcnt(0);
        unsigned nloc = b.st[0], nx = b.st[1];
        if (nloc == 0u) { xcd_barrier_complete(bar, b.x, b.G, nloc, nx); b.st[0] = nloc; b.st[1] = nx; }
        const unsigned old = xb_add(&bar[XB_XSUB(b.x)], 1u);
        const unsigned gen = old / nloc;
        if (old + 1u == (gen + 1u) * nloc) {
            __builtin_amdgcn_fence(__ATOMIC_RELEASE, "agent");
            asm volatile("s_waitcnt vmcnt(0)" ::: "memory");
            const unsigned og = xb_add(&bar[XB_TOP], 1u);
            const unsigned tg = og / nx;
            if (og + 1u == (tg + 1u) * nx) xb_add(&bar[XB_TOPGEN], 1u);
            else XB_SPIN(xb_ld(&bar[XB_TOPGEN]) == tg, bar);
            __builtin_amdgcn_fence(__ATOMIC_ACQUIRE, "agent");
            xb_add(&bar[XB_XGEN(b.x)], 1u);
            asm volatile("s_waitcnt vmcnt(0)" ::: "memory");
        } else {
            XB_SPIN(xb_ld(&bar[XB_XGEN(b.x)]) == gen, bar);
            __builtin_amdgcn_fence(__ATOMIC_ACQUIRE, "agent");
            asm volatile("s_waitcnt vmcnt(0)" ::: "memory");
        }
    }
    __syncthreads();
}

namespace moba {
using bf16x8 = __attribute__((ext_vector_type(8))) short;
using s16x4 = __attribute__((ext_vector_type(4))) short;
using f32x16 = __attribute__((ext_vector_type(16))) float;
using u32x4 = __attribute__((ext_vector_type(4))) unsigned;
typedef short v4i16_t __attribute__((ext_vector_type(4)));
constexpr int NW = 8, QBLK = 32, QB = 256, KVBLK = 64;
constexpr int NSLOT = 3, SLOTB = 8192;
constexpr int LDS_K = 0, LDS_V = NSLOT * SLOTB, LDS_WS = 2 * NSLOT * SLOTB, LDS_OST = LDS_WS + NW * 64 * 4, LDS_TOTAL = LDS_OST + NW * 4096;
__device__ __forceinline__ int crow(int r, int hi) { return (r & 3) + 8 * (r >> 2) + 4 * hi; }
#define MB_SBAR() __builtin_amdgcn_sched_barrier(0)
__device__ __forceinline__ void glds16(const void* gsrc, unsigned lds_dst) { unsigned keep;
    asm volatile("s_mov_b32 %0, m0\n\ts_mov_b32 m0, %2\n\ts_nop 0\n\tglobal_load_lds_dwordx4 %1, off\n\ts_mov_b32 m0, %0" : "=&s"(keep) : "v"(gsrc), "s"(lds_dst) : "memory"); }
typedef float f32x2_t __attribute__((ext_vector_type(2))); typedef __bf16 bf16x2_t __attribute__((ext_vector_type(2)));
__device__ __forceinline__ unsigned cvtpk_s(float lo, float hi) { f32x2_t v = {lo, hi}; bf16x2_t b = __builtin_convertvector(v, bf16x2_t); return __builtin_bit_cast(unsigned, b); }
#define MB_WAIT_BAR(N) asm volatile("s_waitcnt vmcnt(" #N ") lgkmcnt(0)\n\ts_barrier" ::: "memory")
typedef __attribute__((address_space(3))) const char* lds_cptr;

__device__ __forceinline__ void qkt(f32x16& p0, f32x16& p1, lds_cptr Kslot, const bf16x8* qr, const f32x16& cin, int r32, int hi) {
    lds_cptr kb = Kslot + hi * 1024 + r32 * 16;
#pragma unroll
    for (int d0 = 0; d0 < 4; ++d0) {
        const bf16x8 b0 = *(const __attribute__((address_space(3))) bf16x8*)(kb + d0 * 2048);
        const bf16x8 b1 = *(const __attribute__((address_space(3))) bf16x8*)(kb + d0 * 2048 + 512);
        if (d0 == 0) { p0 = __builtin_amdgcn_mfma_f32_32x32x16_bf16(b0, qr[0], cin, 0, 0, 0); p1 = __builtin_amdgcn_mfma_f32_32x32x16_bf16(b1, qr[0], cin, 0, 0, 0); }
        else { p0 = __builtin_amdgcn_mfma_f32_32x32x16_bf16(b0, qr[d0], p0, 0, 0, 0); p1 = __builtin_amdgcn_mfma_f32_32x32x16_bf16(b1, qr[d0], p1, 0, 0, 0); } }
}
__device__ __forceinline__ void pv(f32x16* o, int vb, bf16x8 pa0, bf16x8 pa1, bf16x8 pa2, bf16x8 pa3) {
#pragma unroll
    for (int d0 = 0; d0 < 2; ++d0) { s16x4 lo[4], hi[4];
#pragma unroll
        for (int ks = 0; ks < 4; ++ks) {
            asm volatile("ds_read_b64_tr_b16 %0,%1 offset:%c2" : "=&v"(lo[ks]) : "v"(vb), "i"(d0 * 4096 + ks * 1024) : "memory");
            asm volatile("ds_read_b64_tr_b16 %0,%1 offset:%c2" : "=&v"(hi[ks]) : "v"(vb), "i"(d0 * 4096 + ks * 1024 + 512) : "memory"); }
        asm volatile("s_waitcnt lgkmcnt(0)" ::: "memory"); MB_SBAR();
#define MB_PK(k) (bf16x8){lo[k][0], lo[k][1], lo[k][2], lo[k][3], hi[k][0], hi[k][1], hi[k][2], hi[k][3]}
        o[d0] = __builtin_amdgcn_mfma_f32_32x32x16_bf16(pa0, MB_PK(0), o[d0], 0, 0, 0);
        o[d0] = __builtin_amdgcn_mfma_f32_32x32x16_bf16(pa1, MB_PK(1), o[d0], 0, 0, 0);
        o[d0] = __builtin_amdgcn_mfma_f32_32x32x16_bf16(pa2, MB_PK(2), o[d0], 0, 0, 0);
        o[d0] = __builtin_amdgcn_mfma_f32_32x32x16_bf16(pa3, MB_PK(3), o[d0], 0, 0, 0);
#undef MB_PK
    }
}
__device__ __forceinline__ void pv_read(int vb, s16x4 (&lo)[8], s16x4 (&hi)[8]) {
#pragma unroll
    for (int d0 = 0; d0 < 2; ++d0)
#pragma unroll
        for (int ks = 0; ks < 4; ++ks) {
            asm volatile("ds_read_b64_tr_b16 %0,%1 offset:%c2" : "=&v"(lo[d0 * 4 + ks]) : "v"(vb), "i"(d0 * 4096 + ks * 1024) : "memory");
            asm volatile("ds_read_b64_tr_b16 %0,%1 offset:%c2" : "=&v"(hi[d0 * 4 + ks]) : "v"(vb), "i"(d0 * 4096 + ks * 1024 + 512) : "memory"); }
}
__device__ __forceinline__ void pv_mma(f32x16* o, bf16x8 pa0, bf16x8 pa1, bf16x8 pa2, bf16x8 pa3, s16x4 (&lo)[8], s16x4 (&hi)[8]) {
    asm volatile("s_waitcnt lgkmcnt(0)" : "+v"(lo[0]), "+v"(lo[1]), "+v"(lo[2]), "+v"(lo[3]), "+v"(lo[4]), "+v"(lo[5]), "+v"(lo[6]), "+v"(lo[7]), "+v"(hi[0]), "+v"(hi[1]), "+v"(hi[2]), "+v"(hi[3]), "+v"(hi[4]), "+v"(hi[5]), "+v"(hi[6]), "+v"(hi[7]) :: "memory"); MB_SBAR();
#define MB_PK2(k) (bf16x8){lo[k][0], lo[k][1], lo[k][2], lo[k][3], hi[k][0], hi[k][1], hi[k][2], hi[k][3]}
#pragma unroll
    for (int d0 = 0; d0 < 2; ++d0) {
        o[d0] = __builtin_amdgcn_mfma_f32_32x32x16_bf16(pa0, MB_PK2(d0 * 4 + 0), o[d0], 0, 0, 0);
        o[d0] = __builtin_amdgcn_mfma_f32_32x32x16_bf16(pa1, MB_PK2(d0 * 4 + 1), o[d0], 0, 0, 0);
        o[d0] = __builtin_amdgcn_mfma_f32_32x32x16_bf16(pa2, MB_PK2(d0 * 4 + 2), o[d0], 0, 0, 0);
        o[d0] = __builtin_amdgcn_mfma_f32_32x32x16_bf16(pa3, MB_PK2(d0 * 4 + 3), o[d0], 0, 0, 0); }
#undef MB_PK2
}
__device__ __forceinline__ unsigned bfhi(float x) { hwf2_t v = {x, 0.f}; return __builtin_bit_cast(unsigned, __builtin_convertvector(v, hwb2_t)) & 0xffffu; }

__device__ __forceinline__ void attn_unit(int b, int h, int qb, const bf16* __restrict__ Z, const float* __restrict__ kpart, bf16* __restrict__ mix, LAS unsigned char* shm, const int tid) {
    const int lane = tid & 63, r32 = lane & 31, hi = lane >> 5; const int wid = __builtin_amdgcn_readfirstlane(tid >> 6);
    const long rowbase = (long)b * SEQ; const int q0 = qb * QB;
    const bf16* Qw = Z + (rowbase + q0 + wid * QBLK) * ZP + ZC_AQ + h * 64;
    const bf16* Kh = Z + rowbase * ZP + ZC_AK + h * 64; const bf16* Vh = Z + rowbase * ZP + ZC_AV + h * 64;
    const unsigned lds0 = (unsigned)(uintptr_t)shm;
    LAS float* wsf = (LAS float*)(shm + LDS_WS) + wid * 64;
    const bf16* ksrc = Kh + (long)lane * ZP + wid * 8;
    const bf16* vsrc = Vh + (long)(16 * (wid & 3) + (lane >> 2)) * ZP + (wid >> 2) * 32 + (lane & 3) * 8;
    const unsigned kdst = lds0 + LDS_K + wid * 1024, vdst = lds0 + LDS_V + wid * 1024;
#define MB_DMA_K(t, slot) glds16(ksrc + (long)(t) * KVBLK * ZP, (unsigned)__builtin_amdgcn_readfirstlane(kdst + (slot)))
#define MB_DMA_V(t, slot) glds16(vsrc + (long)(t) * KVBLK * ZP, (unsigned)__builtin_amdgcn_readfirstlane(vdst + (slot)))
    const int vb0 = (int)(lds0 + LDS_V) + ((lane >> 4) & 1) * 32 + (lane & 3) * 8 + (4 * hi + ((lane & 15) >> 2)) * 64;
    const lds_cptr kp0 = (lds_cptr)shm + LDS_K;
    const int NT = 4 * (qb + 1);
    MB_DMA_K(0, 0); MB_DMA_V(0, 0); MB_DMA_K(1, SLOTB); MB_DMA_V(1, SLOTB);
    bf16x8 qr[4];
#pragma unroll
    for (int d0 = 0; d0 < 4; ++d0) qr[d0] = *reinterpret_cast<const bf16x8*>(&Qw[(long)r32 * ZP + d0 * 16 + hi * 8]);
    unsigned selmask = 0u;
    if (qb > 0) {
        f32x16 g = f32x16{};
        const float* kp = kpart + ((size_t)((b * 8 + h) * 32 + r32) * 2) * 64 + hi * 8;
#pragma unroll
        for (int d0 = 0; d0 < 4; ++d0) {
            const f32x4 a0 = *(const f32x4*)(kp + d0 * 16) + *(const f32x4*)(kp + 64 + d0 * 16), a1 = *(const f32x4*)(kp + d0 * 16 + 4) + *(const f32x4*)(kp + 64 + d0 * 16 + 4);
            float v[8] = {a0.x, a0.y, a0.z, a0.w, a1.x, a1.y, a1.z, a1.w}; bf16x8 kh, kl;
#pragma unroll
            for (int j = 0; j < 8; ++j) { const unsigned hb = bfhi(v[j]); kh[j] = (short)hb; kl[j] = (short)bfhi(v[j] - __builtin_bit_cast(float, hb << 16)); }
            g = __builtin_amdgcn_mfma_f32_32x32x16_bf16(kh, qr[d0], g, 0, 0, 0); g = __builtin_amdgcn_mfma_f32_32x32x16_bf16(kl, qr[d0], g, 0, 0, 0); }
#pragma unroll
        for (int r = 0; r < 16; ++r) if (crow(r, hi) >= qb) g[r] = -INFINITY;
#pragma unroll
        for (int k = 0; k < 3; ++k) { float bv = -INFINITY; int bi = 0;
#pragma unroll
            for (int r = 0; r < 16; ++r) if (g[r] > bv) { bv = g[r]; bi = crow(r, hi); }
            const float pvv = __shfl_xor(bv, 32); const int pi = __shfl_xor(bi, 32);
            const bool tp = (pvv > bv) || (pvv == bv && pi < bi); const float best = tp ? pvv : bv; const int besti = tp ? pi : bi;
            if (best > -INFINITY) { selmask |= 1u << besti;
#pragma unroll
                for (int r = 0; r < 16; ++r) if (crow(r, hi) == besti) g[r] = -INFINITY; } }
    }
    float l_reg = 0.f; f32x16 o[2]; o[0] = f32x16{}; o[1] = f32x16{};
    const int qrel = wid * QBLK + r32;
    int slot = 0;
    for (int t = 0; t < NT; ++t) {
        if (t + 1 < NT) MB_WAIT_BAR(2); else MB_WAIT_BAR(0);
        if (t + 2 < NT) { const int s2 = slot >= SLOTB ? slot - SLOTB : slot + 2 * SLOTB; MB_DMA_K(t + 2, s2); MB_DMA_V(t + 2, s2); }
        const int nblk = t >> 2; const bool own = nblk == qb; const bool sel = own || ((selmask >> nblk) & 1u);
        if (__any(sel)) {
            f32x16 cin; const float cv = sel ? 0.f : -1e30f;
#pragma unroll
            for (int r = 0; r < 16; ++r) cin[r] = cv;
            f32x16 p0, p1;
            qkt(p0, p1, kp0 + slot, qr, cin, r32, hi);
            if (own) { const int kb = 64 * (t & 3) + 4 * hi;
#pragma unroll
                for (int r = 0; r < 16; ++r) { const int kv = kb + (r & 3) + 8 * (r >> 2); if (kv > qrel) p0[r] = -1e30f; if (kv + 32 > qrel) p1[r] = -1e30f; } }
            float sacc = 0.f;
#pragma unroll
            for (int r = 0; r < 16; ++r) { p0[r] = __builtin_amdgcn_exp2f(p0[r]); p1[r] = __builtin_amdgcn_exp2f(p1[r]); sacc += p0[r] + p1[r]; }
            l_reg += sacc;
            u32x4 pw0, pw1, pw2, pw3;
            pw0 = (u32x4){cvtpk_s(p0[0], p0[1]), cvtpk_s(p0[2], p0[3]), cvtpk_s(p0[4], p0[5]), cvtpk_s(p0[6], p0[7])};
            pw1 = (u32x4){cvtpk_s(p0[8], p0[9]), cvtpk_s(p0[10], p0[11]), cvtpk_s(p0[12], p0[13]), cvtpk_s(p0[14], p0[15])};
            pw2 = (u32x4){cvtpk_s(p1[0], p1[1]), cvtpk_s(p1[2], p1[3]), cvtpk_s(p1[4], p1[5]), cvtpk_s(p1[6], p1[7])};
            pw3 = (u32x4){cvtpk_s(p1[8], p1[9]), cvtpk_s(p1[10], p1[11]), cvtpk_s(p1[12], p1[13]), cvtpk_s(p1[14], p1[15])};
            MB_SBAR();
            pv(o, vb0 + slot, __builtin_bit_cast(bf16x8, pw0), __builtin_bit_cast(bf16x8, pw1), __builtin_bit_cast(bf16x8, pw2), __builtin_bit_cast(bf16x8, pw3));
        }
        slot = slot == (NSLOT - 1) * SLOTB ? 0 : slot + SLOTB;
    }
    { auto rr = __builtin_amdgcn_permlane32_swap(__float_as_uint(l_reg), __float_as_uint(l_reg), false, false); l_reg = __uint_as_float(rr[0]) + __uint_as_float(rr[1]); }
    if (hi == 0) wsf[32 + r32] = l_reg; asm volatile("s_waitcnt lgkmcnt(0)" ::: "memory");
    float rli[16];
#pragma unroll
    for (int r = 0; r < 16; ++r) rli[r] = __builtin_amdgcn_rcpf(wsf[32 + crow(r, hi)]);
    bf16* Ow = mix + (rowbase + q0 + wid * QBLK) * DM + MC_AT + h * 64;
    { LAS bf16* stg = (LAS bf16*)(shm + LDS_OST) + wid * 2048;
#pragma unroll
      for (int r = 0; r < 16; ++r) { const int orow = crow(r, hi);
#pragma unroll
          for (int d0 = 0; d0 < 2; ++d0) stg[orow * 64 + d0 * 32 + r32] = (bf16)bfhi(o[d0][r] * rli[r]); }
      asm volatile("s_waitcnt lgkmcnt(0)" ::: "memory");
#pragma unroll
      for (int i = 0; i < 4; ++i) { const int row = i * 8 + (lane >> 3), ch = lane & 7; const u32x4 v = *(const LAS u32x4*)(stg + row * 64 + ch * 8); *(u32x4*)(Ow + (long)row * DM + ch * 8) = v; } }
    asm volatile("s_waitcnt lgkmcnt(0)\n\ts_barrier" ::: "memory");
#undef MB_DMA_K
#undef MB_DMA_V
}
constexpr int LCAP = 8192;
constexpr int LDS_OST32 = LDS_WS + NW * 64 * 4, LDS_TOTAL32 = LDS_OST32 + NW * 8192;
struct SelIn { bf16x8 qr[4]; };
constexpr int SKP = 72;
struct SelOut { int n0, n1, n2, r0, r1, r2, nj; unsigned base; };
__device__ __forceinline__ void sel_load(SelIn& in, int b, int h, int qb, const bf16* __restrict__ Z, int wid, int r32, int hi) {
    const bf16* Qw = Z + ((long)b * SEQ + qb * QB + wid * QBLK) * ZP + ZC_AQ + h * 64;
#pragma unroll
    for (int d0 = 0; d0 < 4; ++d0) in.qr[d0] = *reinterpret_cast<const bf16x8*>(&Qw[(long)r32 * ZP + d0 * 16 + hi * 8]);
}
__device__ __forceinline__ void sel_kload(f32x4 (&kv)[2], int b, int h, const float* __restrict__ kpart, int tid) {
    const float* kp = kpart + (size_t)((b * 8 + h) * 32) * 128 + (tid >> 4) * 128 + (tid & 15) * 4; kv[0] = *(const f32x4*)kp; kv[1] = *(const f32x4*)(kp + 64); }
__device__ __forceinline__ void sel_kstore(const f32x4 (&kv)[2], LAS bf16* ks, int tid) {
    const f32x4 a = kv[0] + kv[1]; const float v[4] = {a.x, a.y, a.z, a.w}; unsigned hb[4], lb[4];
#pragma unroll
    for (int j = 0; j < 4; ++j) { hb[j] = bfhi(v[j]); lb[j] = bfhi(v[j] - __builtin_bit_cast(float, hb[j] << 16)); }
    LAS bf16* p = ks + (tid >> 4) * SKP + (tid & 15) * 4;
    typedef unsigned v2u_ __attribute__((ext_vector_type(2)));
    *(LAS v2u_*)p = (v2u_){hb[0] | (hb[1] << 16), hb[2] | (hb[3] << 16)}; *(LAS v2u_*)(p + 32 * SKP) = (v2u_){lb[0] | (lb[1] << 16), lb[2] | (lb[3] << 16)}; }
__device__ __forceinline__ void sel_pick(const SelIn& in, const LAS bf16* ks, SelOut& out, int bh, int qb, unsigned* __restrict__ selcnt, int lane, int hi) {
    unsigned selmask = 0u;
    { f32x16 g = f32x16{};
#pragma unroll
      for (int d0 = 0; d0 < 4; ++d0) {
          const bf16x8 kh = *(const LAS bf16x8*)(ks + (lane & 31) * SKP + d0 * 16 + hi * 8), kl = *(const LAS bf16x8*)(ks + (32 + (lane & 31)) * SKP + d0 * 16 + hi * 8);
          g = __builtin_amdgcn_mfma_f32_32x32x16_bf16(kh, in.qr[d0], g, 0, 0, 0); g = __builtin_amdgcn_mfma_f32_32x32x16_bf16(kl, in.qr[d0], g, 0, 0, 0); }
#pragma unroll
      for (int r = 0; r < 16; ++r) if (crow(r, hi) >= qb) g[r] = -INFINITY;
#pragma unroll
      for (int k = 0; k < 3; ++k) { float bv = -INFINITY; int bi = 0;
#pragma unroll
          for (int r = 0; r < 16; ++r) if (g[r] > bv) { bv = g[r]; bi = crow(r, hi); }
          const float pvv = __shfl_xor(bv, 32); const int pi = __shfl_xor(bi, 32);
          const bool tp = (pvv > bv) || (pvv == bv && pi < bi); const float best = tp ? pvv : bv; const int besti = tp ? pi : bi;
          if (best > -INFINITY) { selmask |= 1u << besti;
#pragma unroll
              for (int r = 0; r < 16; ++r) if (crow(r, hi) == besti) g[r] = -INFINITY; } } }
    out.n0 = out.n1 = out.n2 = out.r0 = out.r1 = out.r2 = out.nj = 0; unsigned mycount = 0u;
    const unsigned long long ltmask = (1ull << lane) - 1ull;
    for (int n = 0; n < qb; ++n) { const bool s = ((selmask >> n) & 1u) && hi == 0; const unsigned long long bal = __ballot(s); const int rank = __popcll(bal & ltmask);
        if (s) { if (out.nj == 0) { out.n0 = n; out.r0 = rank; } else if (out.nj == 1) { out.n1 = n; out.r1 = rank; } else { out.n2 = n; out.r2 = rank; } ++out.nj; }
        if (lane == n) mycount = (unsigned)__popcll(bal); }
    out.base = 0u;
    if (lane < qb && mycount) out.base = atomicAdd(selcnt + bh * 32 + lane, mycount);
}
__device__ __forceinline__ void sel_write(const SelOut& o, int bh, int qb, unsigned* __restrict__ list, int wid, int r32, int hi) {
    const unsigned b0 = __shfl(o.base, o.n0), b1 = __shfl(o.base, o.n1), b2 = __shfl(o.base, o.n2);
    const unsigned t = (unsigned)(qb * QB + wid * QBLK + r32);
    if (hi == 0) { if (o.nj > 0) list[(size_t)(bh * 32 + o.n0) * LCAP + b0 + o.r0] = (t << 2) | 0u; if (o.nj > 1) list[(size_t)(bh * 32 + o.n1) * LCAP + b1 + o.r1] = (t << 2) | 1u; if (o.nj > 2) list[(size_t)(bh * 32 + o.n2) * LCAP + b2 + o.r2] = (t << 2) | 2u; }
}
struct SelKeep { unsigned pk, base; };
__device__ __forceinline__ SelKeep sel_keep(const SelOut& o) { SelKeep k; k.pk = (unsigned)o.n0 | ((unsigned)o.n1 << 5) | ((unsigned)o.n2 << 10) | ((unsigned)o.r0 << 15) | ((unsigned)o.r1 << 20) | ((unsigned)o.r2 << 25) | ((unsigned)o.nj << 30); k.base = o.base; return k; }
__device__ __forceinline__ SelOut sel_unkeep(const SelKeep& k) { SelOut o; o.n0 = k.pk & 31; o.n1 = (k.pk >> 5) & 31; o.n2 = (k.pk >> 10) & 31; o.r0 = (k.pk >> 15) & 31; o.r1 = (k.pk >> 20) & 31; o.r2 = (k.pk >> 25) & 31; o.nj = k.pk >> 30; o.base = k.base; return o; }
__device__ __forceinline__ void sel_front(SelKeep& kA, SelKeep& kB, int b, int hA, int qbA, int hB, int qbB, const bf16* __restrict__ Z, const float* __restrict__ kpart, unsigned* __restrict__ selcnt, LAS unsigned char* shm, const int tid) {
    const int lane = tid & 63, r32 = lane & 31, hi = lane >> 5; const int wid = __builtin_amdgcn_readfirstlane(tid >> 6);
    LAS bf16* ks = (LAS bf16*)shm;
    SelIn iA, iB; SelOut oA, oB; f32x4 kvA[2], kvB[2];
    sel_kload(kvA, b, hA, kpart, tid); sel_kload(kvB, b, hB, kpart, tid);
    sel_load(iA, b, hA, qbA, Z, wid, r32, hi); sel_load(iB, b, hB, qbB, Z, wid, r32, hi);
    __syncthreads();
    sel_kstore(kvA, ks, tid); sel_kstore(kvB, ks + 64 * SKP, tid);
    __syncthreads();
    sel_pick(iA, ks, oA, b * 8 + hA, qbA, selcnt, lane, hi); sel_pick(iB, ks + 64 * SKP, oB, b * 8 + hB, qbB, selcnt, lane, hi);
    kA = sel_keep(oA); kB = sel_keep(oB);
    { LAS unsigned* kp_ = (LAS unsigned*)(shm + 114688) + tid * 2; kp_[0] = kA.pk; kp_[1] = kB.pk; kA.pk = 0u; kB.pk = 0u; }
    __syncthreads();
}
__device__ __forceinline__ void sel_back(SelKeep kA, SelKeep kB, int b, int hA, int qbA, int hB, int qbB, unsigned* __restrict__ list, LAS unsigned char* shm, const int tid) {
    { const LAS unsigned* kp_ = (const LAS unsigned*)(shm + 114688) + tid * 2; kA.pk = kp_[0]; kB.pk = kp_[1]; }
    const int lane = tid & 63, r32 = lane & 31, hi = lane >> 5; const int wid = __builtin_amdgcn_readfirstlane(tid >> 6);
    const SelOut oA = sel_unkeep(kA), oB = sel_unkeep(kB);
    sel_write(oA, b * 8 + hA, qbA, list, wid, r32, hi); sel_write(oB, b * 8 + hB, qbB, list, wid, r32, hi);
}
__device__ __forceinline__ void tiles_prefetch(const bf16* Kh, const bf16* Vh, int tile0, LAS unsigned char* shm, const int lane, const int wid) {
    const unsigned lds0 = (unsigned)(uintptr_t)shm;
    const bf16* ksrc = Kh + (long)lane * ZP + wid * 8 + (long)tile0 * KVBLK * ZP;
    const bf16* vsrc = Vh + (long)(16 * (wid & 3) + (lane >> 2)) * ZP + (wid >> 2) * 32 + (lane & 3) * 8 + (long)tile0 * KVBLK * ZP;
    const unsigned kdst = lds0 + LDS_K + wid * 1024, vdst = lds0 + LDS_V + wid * 1024;
    glds16(ksrc, (unsigned)__builtin_amdgcn_readfirstlane(kdst)); glds16(vsrc, (unsigned)__builtin_amdgcn_readfirstlane(vdst));
    glds16(ksrc + (long)KVBLK * ZP, (unsigned)__builtin_amdgcn_readfirstlane(kdst + SLOTB)); glds16(vsrc + (long)KVBLK * ZP, (unsigned)__builtin_amdgcn_readfirstlane(vdst + SLOTB));
}
template <int MODE, int SLOT0 = 0, bool CHAIN = false> __device__ __forceinline__ void four_tiles(f32x16 (&o)[2], float& l_reg, const bf16x8 (&qr)[4], const bf16* Kh, const bf16* Vh, int tile0, bool active, int qrel,
                                                                LAS unsigned char* shm, const int lane, const int wid, const bf16* nKh = nullptr, const bf16* nVh = nullptr, int ntile0 = 0) {
    const int r32 = lane & 31, hi = lane >> 5; const unsigned lds0 = (unsigned)(uintptr_t)shm;
    const bf16* ksrc = Kh + (long)lane * ZP + wid * 8 + (long)tile0 * KVBLK * ZP;
    const bf16* vsrc = Vh + (long)(16 * (wid & 3) + (lane >> 2)) * ZP + (wid >> 2) * 32 + (lane & 3) * 8 + (long)tile0 * KVBLK * ZP;
    const unsigned kdst = lds0 + LDS_K + wid * 1024, vdst = lds0 + LDS_V + wid * 1024;
#define MB_DMA_K(t, slot) glds16(ksrc + (long)(t) * KVBLK * ZP, (unsigned)__builtin_amdgcn_readfirstlane(kdst + (slot)))
#define MB_DMA_V(t, slot) glds16(vsrc + (long)(t) * KVBLK * ZP, (unsigned)__builtin_amdgcn_readfirstlane(vdst + (slot)))
    const int vb0 = (int)(lds0 + LDS_V) + ((lane >> 4) & 1) * 32 + (lane & 3) * 8 + (4 * hi + ((lane & 15) >> 2)) * 64;
    const lds_cptr kp0 = (lds_cptr)shm + LDS_K;
    int slot = SLOT0;
#pragma unroll
    for (int t = 0; t < 4; ++t) {
        if (t + 1 < 4) { if (MODE == 1 && t < 2) MB_WAIT_BAR(18); else MB_WAIT_BAR(2); } else MB_WAIT_BAR(0);
        if (t + 2 < 4) { const int s2 = slot >= SLOTB ? slot - SLOTB : slot + 2 * SLOTB; MB_DMA_K(t + 2, s2); MB_DMA_V(t + 2, s2); }
        if (CHAIN && t == 3) {
            const int sA = slot == (NSLOT - 1) * SLOTB ? 0 : slot + SLOTB, sB = sA == (NSLOT - 1) * SLOTB ? 0 : sA + SLOTB;
            const bf16* nk = nKh + (long)lane * ZP + wid * 8 + (long)ntile0 * KVBLK * ZP; const bf16* nv = nVh + (long)(16 * (wid & 3) + (lane >> 2)) * ZP + (wid >> 2) * 32 + (lane & 3) * 8 + (long)ntile0 * KVBLK * ZP;
            glds16(nk, (unsigned)__builtin_amdgcn_readfirstlane(kdst + sA)); glds16(nv, (unsigned)__builtin_amdgcn_readfirstlane(vdst + sA));
            glds16(nk + (long)KVBLK * ZP, (unsigned)__builtin_amdgcn_readfirstlane(kdst + sB)); glds16(nv + (long)KVBLK * ZP, (unsigned)__builtin_amdgcn_readfirstlane(vdst + sB)); }
        if (active) {
            const f32x16 cin = f32x16{};
            f32x16 p0, p1;
            qkt(p0, p1, kp0 + slot, qr, cin, r32, hi);
            s16x4 vlo[8], vhi[8]; pv_read(vb0 + slot, vlo, vhi);
            if (MODE == 1) { const int thr = qrel - (64 * t + 4 * hi);
#pragma unroll
                for (int r = 0; r < 16; ++r) { const int c = (r & 3) + 8 * (r >> 2); if (c > thr) p0[r] = -1e30f; if (c + 32 > thr) p1[r] = -1e30f; } }
            float sacc = 0.f;
#pragma unroll
            for (int r = 0; r < 16; ++r) { p0[r] = __builtin_amdgcn_exp2f(p0[r]); p1[r] = __builtin_amdgcn_exp2f(p1[r]); sacc += p0[r] + p1[r]; }
            l_reg += sacc;
            u32x4 pw0, pw1, pw2, pw3;
            pw0 = (u32x4){cvtpk_s(p0[0], p0[1]), cvtpk_s(p0[2], p0[3]), cvtpk_s(p0[4], p0[5]), cvtpk_s(p0[6], p0[7])};
            pw1 = (u32x4){cvtpk_s(p0[8], p0[9]), cvtpk_s(p0[10], p0[11]), cvtpk_s(p0[12], p0[13]), cvtpk_s(p0[14], p0[15])};
            pw2 = (u32x4){cvtpk_s(p1[0], p1[1]), cvtpk_s(p1[2], p1[3]), cvtpk_s(p1[4], p1[5]), cvtpk_s(p1[6], p1[7])};
            pw3 = (u32x4){cvtpk_s(p1[8], p1[9]), cvtpk_s(p1[10], p1[11]), cvtpk_s(p1[12], p1[13]), cvtpk_s(p1[14], p1[15])};
            MB_SBAR();
            pv_mma(o, __builtin_bit_cast(bf16x8, pw0), __builtin_bit_cast(bf16x8, pw1), __builtin_bit_cast(bf16x8, pw2), __builtin_bit_cast(bf16x8, pw3), vlo, vhi);
        }
        slot = slot == (NSLOT - 1) * SLOTB ? 0 : slot + SLOTB;
    }
#undef MB_DMA_K
#undef MB_DMA_V
}
__device__ __forceinline__ void sparse_unit(int bh, int n, int chunk, int cnt, const bf16* __restrict__ Z, const unsigned* __restrict__ list, bf16* __restrict__ parto, float* __restrict__ partl, LAS unsigned char* shm, const int tid) {
    const int lane = tid & 63, r32 = lane & 31, hi = lane >> 5; const int wid = __builtin_amdgcn_readfirstlane(tid >> 6);
    const int b = bh >> 3, h = bh & 7; const long rowbase = (long)b * SEQ;
    tiles_prefetch(Z + rowbase * ZP + ZC_AK + h * 64, Z + rowbase * ZP + ZC_AV + h * 64, 4 * n, shm, lane, wid);
    const int e = chunk * 256 + wid * QBLK + r32; const bool valid = e < cnt;
    const unsigned entry = valid ? list[(size_t)(bh * 32 + n) * LCAP + e] : 0u; const int t = (int)(entry >> 2);
    const bool active = (chunk * 256 + wid * QBLK) < cnt;
    const bf16* Qrow = Z + (rowbase + t) * ZP + ZC_AQ + h * 64;
    bf16x8 qr[4];
#pragma unroll
    for (int d0 = 0; d0 < 4; ++d0) qr[d0] = *reinterpret_cast<const bf16x8*>(&Qrow[d0 * 16 + hi * 8]);
    float l_reg = 0.f; f32x16 o[2]; o[0] = f32x16{}; o[1] = f32x16{};
    four_tiles<0>(o, l_reg, qr, Z + rowbase * ZP + ZC_AK + h * 64, Z + rowbase * ZP + ZC_AV + h * 64, 4 * n, active, 0, shm, lane, wid);
    LAS float* wsf = (LAS float*)(shm + LDS_WS) + wid * 64;
    { auto rr = __builtin_amdgcn_permlane32_swap(__float_as_uint(l_reg), __float_as_uint(l_reg), false, false); l_reg = __uint_as_float(rr[0]) + __uint_as_float(rr[1]); }
    if (active) {
        if (hi == 0) wsf[32 + r32] = l_reg; asm volatile("s_waitcnt lgkmcnt(0)" ::: "memory");
        float rli[16];
#pragma unroll
        for (int r = 0; r < 16; ++r) rli[r] = __builtin_amdgcn_rcpf(wsf[32 + crow(r, hi)]);
        LAS bf16* stg = (LAS bf16*)(shm + LDS_OST) + wid * 2048;
#pragma unroll
        for (int r = 0; r < 16; ++r) { const int orow = crow(r, hi);
#pragma unroll
            for (int d0 = 0; d0 < 2; ++d0) stg[orow * 64 + d0 * 32 + r32] = (bf16)bfhi(o[d0][r] * rli[r]); }
        asm volatile("s_waitcnt lgkmcnt(0)" ::: "memory");
        if (hi == 0 && valid) partl[((size_t)bh * SEQ + t) * 3 + (entry & 3u)] = l_reg;
#pragma unroll
        for (int i = 0; i < 4; ++i) { const int row = i * 8 + (lane >> 3), ch = lane & 7; const unsigned er = __shfl(entry, row); const bool vr = __shfl((int)valid, row) != 0;
            const u32x4 v = *(const LAS u32x4*)(stg + row * 64 + ch * 8);
            if (vr) *(u32x4*)(parto + (((size_t)bh * SEQ + (er >> 2)) * 3 + (er & 3u)) * 64 + ch * 8) = v; }
    }
    asm volatile("s_waitcnt lgkmcnt(0)\n\ts_barrier" ::: "memory");
}
template <int SLOT0 = 0, bool PREF = false, bool CHAIN = false> __device__ __forceinline__ void own_unit(int b, int h, int qb, const bf16* __restrict__ Z, const bf16* __restrict__ parto, const float* __restrict__ partl, bf16* __restrict__ mix, LAS unsigned char* shm, const int tid, int nh = 0, int nqb = 0) {
    const int lane = tid & 63, r32 = lane & 31, hi = lane >> 5; const int wid = __builtin_amdgcn_readfirstlane(tid >> 6);
    const long rowbase = (long)b * SEQ; const int q0 = qb * QB, bh = b * 8 + h;
    if (!PREF) tiles_prefetch(Z + rowbase * ZP + ZC_AK + h * 64, Z + rowbase * ZP + ZC_AV + h * 64, 4 * qb, shm, lane, wid);
    const bf16* Qw = Z + (rowbase + q0 + wid * QBLK) * ZP + ZC_AQ + h * 64;
    bf16x8 qr[4];
#pragma unroll
    for (int d0 = 0; d0 < 4; ++d0) qr[d0] = *reinterpret_cast<const bf16x8*>(&Qw[(long)r32 * ZP + d0 * 16 + hi * 8]);
    const int nv = qb < 3 ? qb : 3;
    v4u pp[4][3]; float pl[4][3];
#pragma unroll
    for (int i = 0; i < 4; ++i) { const size_t pr = ((size_t)bh * SEQ + q0 + wid * QBLK + i * 8 + (lane >> 3)) * 3;
#pragma unroll
        for (int j = 0; j < 3; ++j) { pl[i][j] = partl[pr + j]; pp[i][j] = *(const v4u*)(parto + (pr + j) * 64 + (lane & 7) * 8); } }
    float l_reg = 0.f; f32x16 o[2]; o[0] = f32x16{}; o[1] = f32x16{};
    four_tiles<1, SLOT0, CHAIN>(o, l_reg, qr, Z + rowbase * ZP + ZC_AK + h * 64, Z + rowbase * ZP + ZC_AV + h * 64, 4 * qb, true, wid * QBLK + r32, shm, lane, wid,
                                Z + rowbase * ZP + ZC_AK + nh * 64, Z + rowbase * ZP + ZC_AV + nh * 64, 4 * nqb);
    LAS float* wsf = (LAS float*)(shm + LDS_WS) + wid * 64;
    { auto rr = __builtin_amdgcn_permlane32_swap(__float_as_uint(l_reg), __float_as_uint(l_reg), false, false); l_reg = __uint_as_float(rr[0]) + __uint_as_float(rr[1]); }
    if (hi == 0) wsf[32 + r32] = l_reg;
    LAS float* stg = (LAS float*)(shm + LDS_OST32) + wid * 2048;
#pragma unroll
    for (int r = 0; r < 16; ++r) { const int orow = crow(r, hi);
#pragma unroll
        for (int d0 = 0; d0 < 2; ++d0) stg[orow * 64 + d0 * 32 + r32] = o[d0][r]; }
    asm volatile("s_waitcnt lgkmcnt(0)" ::: "memory");
    bf16* Ow = mix + (rowbase + q0 + wid * QBLK) * DM + MC_AT + h * 64;
#pragma unroll
    for (int i = 0; i < 4; ++i) { const int row = i * 8 + (lane >> 3), ch = lane & 7;
        f32x4 a0 = *(const LAS f32x4*)(stg + row * 64 + ch * 8), a1 = *(const LAS f32x4*)(stg + row * 64 + ch * 8 + 4); float lt = wsf[32 + row];
#pragma unroll
        for (int j = 0; j < 3; ++j) { const bool on = j < nv; const float lj = on ? pl[i][j] : 0.f; v4u pv_ = pp[i][j]; if (!on) pv_ = (v4u){0u, 0u, 0u, 0u}; lt += lj;
            a0.x += lj * bf2f(pv_.x); a0.y += lj * bf2f(pv_.x >> 16); a0.z += lj * bf2f(pv_.y); a0.w += lj * bf2f(pv_.y >> 16);
            a1.x += lj * bf2f(pv_.z); a1.y += lj * bf2f(pv_.z >> 16); a1.z += lj * bf2f(pv_.w); a1.w += lj * bf2f(pv_.w >> 16); }
        const float rl = __builtin_amdgcn_rcpf(lt);
        v4u ov; ov.x = cvtpk_s(a0.x * rl, a0.y * rl); ov.y = cvtpk_s(a0.z * rl, a0.w * rl); ov.z = cvtpk_s(a1.x * rl, a1.y * rl); ov.w = cvtpk_s(a1.z * rl, a1.w * rl);
        *(v4u*)(Ow + (long)row * DM + ch * 8) = ov; }
    asm volatile("s_waitcnt lgkmcnt(0)\n\ts_barrier" ::: "memory");
}
struct SUnit { int li, chunk, cnt; };
__device__ __forceinline__ SUnit s2_decode(int u, const LAS unsigned* pre, const unsigned* __restrict__ selcnt_l, int h) {
    int lo = 0, hi = 256;
    while (hi - lo > 1) { const int mid = (lo + hi) >> 1; if ((int)pre[mid] <= u) lo = mid; else hi = mid; }
    SUnit s; s.li = 256 * h + lo; s.chunk = u - (int)pre[lo]; s.cnt = (int)selcnt_l[s.li]; return s;
}
__device__ __forceinline__ void sparse_stream(int u0, int ustride, int total, int h, const LAS unsigned* pre, const unsigned* __restrict__ selcnt_l, const bf16* __restrict__ Z, const unsigned* __restrict__ list,
                                              bf16* __restrict__ parto, float* __restrict__ partl, LAS unsigned char* shm, const int tid) {
    if (u0 >= total) return;
    const int lane = tid & 63, r32 = lane & 31, hi = lane >> 5; const int wid = __builtin_amdgcn_readfirstlane(tid >> 6);
    const unsigned lds0 = (unsigned)(uintptr_t)shm;
    const unsigned kdst = lds0 + LDS_K + wid * 1024, vdst = lds0 + LDS_V + wid * 1024;
    const long klane = (long)lane * ZP + wid * 8 + ZC_AK, vlane = (long)(16 * (wid & 3) + (lane >> 2)) * ZP + (wid >> 2) * 32 + (lane & 3) * 8 + ZC_AV;
    const int vb0 = (int)(lds0 + LDS_V) + ((lane >> 4) & 1) * 32 + (lane & 3) * 8 + (4 * hi + ((lane & 15) >> 2)) * 64;
    const lds_cptr kp0 = (lds_cptr)shm + LDS_K;
    LAS float* wsf = (LAS float*)(shm + LDS_WS) + wid * 64;
    LAS bf16* stg = (LAS bf16*)(shm + LDS_OST) + wid * 2048;
#define S2_DMA(U, tl, sl) do { const long rb_ = ((long)((U).li >> 8) * SEQ + (long)(4 * ((U).li & 31) + (tl)) * KVBLK) * ZP + (((U).li >> 5) & 7) * 64; \
        glds16(Z + rb_ + klane, (unsigned)__builtin_amdgcn_readfirstlane(kdst + (sl))); glds16(Z + rb_ + vlane, (unsigned)__builtin_amdgcn_readfirstlane(vdst + (sl))); } while (0)
    int uk = 0; SUnit cu; cu.li = (int)pre[900]; cu.chunk = (int)pre[901]; cu.cnt = (int)pre[902];
    S2_DMA(cu, 0, 0); S2_DMA(cu, 1, SLOTB);
    unsigned entry; bool valid; bf16x8 qr[4];
    { const int e = cu.chunk * 256 + wid * QBLK + r32; valid = e < cu.cnt; entry = valid ? list[(size_t)cu.li * LCAP + e] : 0u;
      const bf16* Qrow = Z + ((long)(cu.li >> 8) * SEQ + (long)(entry >> 2)) * ZP + ZC_AQ + ((cu.li >> 5) & 7) * 64;
#pragma unroll
      for (int d0 = 0; d0 < 4; ++d0) qr[d0] = *reinterpret_cast<const bf16x8*>(&Qrow[d0 * 16 + hi * 8]); }
    int slot = 0;
    for (int u = u0;;) {
        const int un = u + ustride; const bool has_next = un < total;
        SUnit nu = cu; if (has_next) { nu.li = (int)pre[904 + 4 * uk]; nu.chunk = (int)pre[905 + 4 * uk]; nu.cnt = (int)pre[906 + 4 * uk]; }
        unsigned nentry = 0u; bool nvalid = false; bf16x8 nqr[4];
#pragma unroll
        for (int d0 = 0; d0 < 4; ++d0) nqr[d0] = qr[d0];
        const bool active = (cu.chunk * 256 + wid * QBLK) < cu.cnt;
        float l_reg = 0.f; f32x16 o[2]; o[0] = f32x16{}; o[1] = f32x16{};
#pragma unroll
        for (int t = 0; t < 4; ++t) {
            if (t == 0) MB_WAIT_BAR(6);
            else if (t < 3) MB_WAIT_BAR(2); else { if (has_next) MB_WAIT_BAR(2); else MB_WAIT_BAR(0); }
            if (t == 1 && has_next) { const int e = nu.chunk * 256 + wid * QBLK + r32; nvalid = e < nu.cnt; nentry = nvalid ? list[(size_t)nu.li * LCAP + e] : 0u; }
            if (t == 3 && has_next) { const bf16* Qrow = Z + ((long)(nu.li >> 8) * SEQ + (long)(nentry >> 2)) * ZP + ZC_AQ + ((nu.li >> 5) & 7) * 64;
#pragma unroll
                for (int d0 = 0; d0 < 4; ++d0) nqr[d0] = *reinterpret_cast<const bf16x8*>(&Qrow[d0 * 16 + hi * 8]); }
            { const int s2 = slot >= SLOTB ? slot - SLOTB : slot + 2 * SLOTB;
              if (t + 2 < 4) S2_DMA(cu, t + 2, s2); else if (has_next) S2_DMA(nu, t - 2, s2); }
            if (active) {
                const f32x16 cin = f32x16{};
                f32x16 p0, p1;
                qkt(p0, p1, kp0 + slot, qr, cin, r32, hi);
                s16x4 vlo[8], vhi[8]; pv_read(vb0 + slot, vlo, vhi);
                float sacc = 0.f;
#pragma unroll
                for (int r = 0; r < 16; ++r) { p0[r] = __builtin_amdgcn_exp2f(p0[r]); p1[r] = __builtin_amdgcn_exp2f(p1[r]); sacc += p0[r] + p1[r]; }
                l_reg += sacc;
                u32x4 pw0, pw1, pw2, pw3;
                pw0 = (u32x4){cvtpk_s(p0[0], p0[1]), cvtpk_s(p0[2], p0[3]), cvtpk_s(p0[4], p0[5]), cvtpk_s(p0[6], p0[7])};
                pw1 = (u32x4){cvtpk_s(p0[8], p0[9]), cvtpk_s(p0[10], p0[11]), cvtpk_s(p0[12], p0[13]), cvtpk_s(p0[14], p0[15])};
                pw2 = (u32x4){cvtpk_s(p1[0], p1[1]), cvtpk_s(p1[2], p1[3]), cvtpk_s(p1[4], p1[5]), cvtpk_s(p1[6], p1[7])};
                pw3 = (u32x4){cvtpk_s(p1[8], p1[9]), cvtpk_s(p1[10], p1[11]), cvtpk_s(p1[12], p1[13]), cvtpk_s(p1[14], p1[15])};
                MB_SBAR();
                pv_mma(o, __builtin_bit_cast(bf16x8, pw0), __builtin_bit_cast(bf16x8, pw1), __builtin_bit_cast(bf16x8, pw2), __builtin_bit_cast(bf16x8, pw3), vlo, vhi);
            }
            slot = slot == (NSLOT - 1) * SLOTB ? 0 : slot + SLOTB;
        }
        { auto rr = __builtin_amdgcn_permlane32_swap(__float_as_uint(l_reg), __float_as_uint(l_reg), false, false); l_reg = __uint_as_float(rr[0]) + __uint_as_float(rr[1]); }
        if (active) {
            const int bh = cu.li >> 5;
            if (hi == 0) wsf[32 + r32] = l_reg; asm volatile("s_waitcnt lgkmcnt(0)" ::: "memory");
            float rli[16];
#pragma unroll
            for (int r = 0; r < 16; ++r) rli[r] = __builtin_amdgcn_rcpf(wsf[32 + crow(r, hi)]);
#pragma unroll
            for (int r = 0; r < 16; ++r) { const int orow = crow(r, hi);
#pragma unroll
                for (int d0 = 0; d0 < 2; ++d0) stg[orow * 64 + d0 * 32 + r32] = (bf16)bfhi(o[d0][r] * rli[r]); }
            asm volatile("s_waitcnt lgkmcnt(0)" ::: "memory");
            if (hi == 0 && valid) partl[((size_t)bh * SEQ + (entry >> 2)) * 3 + (entry & 3u)] = l_reg;
#pragma unroll
            for (int i = 0; i < 4; ++i) { const int row = i * 8 + (lane >> 3), ch = lane & 7; const unsigned er = __shfl(entry, row); const bool vr = __shfl((int)valid, row) != 0;
                const u32x4 v = *(const LAS u32x4*)(stg + row * 64 + ch * 8);
                if (vr) *(u32x4*)(parto + (((size_t)bh * SEQ + (er >> 2)) * 3 + (er & 3u)) * 64 + ch * 8) = v; }
            asm volatile("s_waitcnt lgkmcnt(0)" ::: "memory");
        }
        if (!has_next) break;
        cu = nu; entry = nentry; valid = nvalid; u = un; ++uk;
#pragma unroll
        for (int d0 = 0; d0 < 4; ++d0) qr[d0] = nqr[d0];
    }
    asm volatile("s_waitcnt lgkmcnt(0)\n\ts_barrier" ::: "memory");
#undef S2_DMA
}
}

namespace mlx {
typedef short bf16x8 __attribute__((ext_vector_type(8)));
typedef short bf16x4 __attribute__((ext_vector_type(4)));
typedef float f32x4 __attribute__((ext_vector_type(4)));
constexpr int L = 128, NC = SEQ / L;
constexpr float LOG2E = 1.4426950408889634f;
__device__ __forceinline__ float silu_(float x) { return x * __builtin_amdgcn_rcpf(1.f + __builtin_amdgcn_exp2f(-LOG2E * x)); }
__device__ __forceinline__ float logsig_(float x) { return fminf(x, 0.f) - __logf(1.f + __expf(-fabsf(x))); }
template <int CTRL, int RM, bool BC> __device__ __forceinline__ float dppx(float old, float src) { return __builtin_bit_cast(float, __builtin_amdgcn_update_dpp(__builtin_bit_cast(int, old), __builtin_bit_cast(int, src), CTRL, RM, 0xf, BC)); }
template <int CTRL, int RM> __device__ __forceinline__ unsigned dppu(unsigned src) { return (unsigned)__builtin_amdgcn_update_dpp(0, (int)src, CTRL, RM, 0xf, true); }
__device__ __forceinline__ float wave_scan_add(float x) {
    x += dppx<0x111, 0xf, true>(0.f, x); x += dppx<0x112, 0xf, true>(0.f, x); x += dppx<0x114, 0xf, true>(0.f, x); x += dppx<0x118, 0xf, true>(0.f, x);
    x += dppx<0x142, 0xa, true>(0.f, x); x += dppx<0x143, 0xc, true>(0.f, x); return x; }
__device__ __forceinline__ unsigned wave_scan_add(unsigned x) {
    x += dppu<0x111, 0xf>(x); x += dppu<0x112, 0xf>(x); x += dppu<0x114, 0xf>(x); x += dppu<0x118, 0xf>(x); x += dppu<0x142, 0xa>(x); x += dppu<0x143, 0xc>(x); return x; }
__device__ __forceinline__ float wave_scan_max(float x) { const float NI = -INFINITY;
    x = fmaxf(x, dppx<0x111, 0xf, false>(NI, x)); x = fmaxf(x, dppx<0x112, 0xf, false>(NI, x)); x = fmaxf(x, dppx<0x114, 0xf, false>(NI, x)); x = fmaxf(x, dppx<0x118, 0xf, false>(NI, x));
    x = fmaxf(x, dppx<0x142, 0xa, false>(NI, x)); x = fmaxf(x, dppx<0x143, 0xc, false>(NI, x)); return x; }
__device__ __forceinline__ float scan_add64(float x, int) { return wave_scan_add(x); }
__device__ __forceinline__ float scan_max64(float x, int) { return wave_scan_max(x); }
__device__ __forceinline__ void conv8_load(const bf16* zp, int t, v4u (&zv)[4]) {
#pragma unroll
    for (int j = 0; j < 4; ++j) zv[j] = *(const v4u*)(zp + (t - 3 + j >= 0 ? (long)(j - 3) * ZP : 0l));
}
__device__ __forceinline__ void conv8_math(const v4u (&zv)[4], int t, const float* w, float (&y)[8]) {
#pragma unroll
    for (int i = 0; i < 8; ++i) y[i] = 0.f;
#pragma unroll
    for (int j = 0; j < 4; ++j) { const float ok = t - 3 + j >= 0 ? 1.f : 0.f; const f32x4 w0 = *(const f32x4*)(w + j * 512) * ok, w1 = *(const f32x4*)(w + j * 512 + 4) * ok;
        y[0] += w0.x * bf2f(zv[j].x); y[1] += w0.y * bf2f(zv[j].x >> 16); y[2] += w0.z * bf2f(zv[j].y); y[3] += w0.w * bf2f(zv[j].y >> 16);
        y[4] += w1.x * bf2f(zv[j].z); y[5] += w1.y * bf2f(zv[j].z >> 16); y[6] += w1.z * bf2f(zv[j].w); y[7] += w1.w * bf2f(zv[j].w >> 16); }
#pragma unroll
    for (int i = 0; i < 8; ++i) y[i] = silu_(y[i]);
}
constexpr int PQ = 72, PV_ = 136;
constexpr int O_QS = 0, O_KS = O_QS + 128 * PQ * 2, O_VT = O_KS + 128 * PQ * 2, O_CT = O_VT + 64 * PV_ * 2, O_F = O_CT + 64 * PQ * 2;
constexpr int F_G = 0, F_U = 128, F_W = 256, F_M = 384, F_A = 512, F_E = 640, F_QN = 768, F_DEN = 896, F_TMP = 1024, F_NP = 1040, F_END = 1104;
constexpr int O_STG = O_F + F_END * 4;
constexpr int LDS_NEED = O_STG + 8 * 4096;

__device__ __forceinline__ void unit_a(int bh, int c, int l, const bf16* __restrict__ Z, const float* __restrict__ gates, const float* __restrict__ mconv,
                                       float* __restrict__ DLOC, float* __restrict__ NLOC, float* __restrict__ SCAL, LAS unsigned char* shm, const int tid) {
    const int lane = tid & 63, wid = __builtin_amdgcn_readfirstlane(tid >> 6), b = bh >> 2, h = bh & 3;
    const long row0 = (long)b * SEQ + (long)c * L;
    LAS float* F = (LAS float*)(shm + O_F); LAS bf16* Ktw = (LAS bf16*)(shm + O_KS); LAS bf16* Vt = (LAS bf16*)(shm + O_VT);
    v4u zk[2][4], vv[2];
#pragma unroll
    for (int i = 0; i < 2; ++i) { const int item = tid + 512 * i, s = item >> 3, dg = item & 7;
        conv8_load(Z + (row0 + s) * ZP + ZC_MK + 64 * h + 8 * dg, c * L + s, zk[i]); vv[i] = *(const v4u*)(Z + (row0 + s) * ZP + ZC_MV + 64 * h + 8 * dg); }
    float gs = 0.f, us = 0.f;
    if (tid < 128) { const float ip = gates[(row0 + tid) * 8 + h], fp = gates[(row0 + tid) * 8 + 4 + h]; gs = scan_add64(logsig_(fp), lane); us = ip; if (tid == 63) F[F_TMP] = gs; }
    __syncthreads();
    if (tid < 128) { if (tid >= 64) gs += F[F_TMP]; us -= gs; F[F_U + tid] = us; if (tid == 127) F[F_TMP + 1] = gs; float mx = us;
        mx = wave_scan_max(mx);
        if (lane == 63) F[F_TMP + 2 + wid] = mx; }
    __syncthreads();
    const float gl = F[F_TMP + 1], mloc = gl + fmaxf(F[F_TMP + 2], F[F_TMP + 3]);
    if (tid < 128) F[F_W + tid] = __expf(gl + us - mloc);
    __syncthreads();
#pragma unroll
    for (int i = 0; i < 2; ++i) { const int item = tid + 512 * i, s = item >> 3, dg = item & 7; float y[8];
        conv8_math(zk[i], c * L + s, mconv + 256 + 64 * h + 8 * dg, y);
        const float wk = F[F_W + s] * 0.125f;
#pragma unroll
        for (int j = 0; j < 8; ++j) Ktw[(8 * dg + j) * PV_ + s] = (bf16)f2bf(y[j] * wk);
        const v4u v1 = vv[i];
        Vt[(8 * dg + 0) * PV_ + s] = (bf16)(v1.x & 0xffffu); Vt[(8 * dg + 1) * PV_ + s] = (bf16)(v1.x >> 16); Vt[(8 * dg + 2) * PV_ + s] = (bf16)(v1.y & 0xffffu); Vt[(8 * dg + 3) * PV_ + s] = (bf16)(v1.y >> 16);
        Vt[(8 * dg + 4) * PV_ + s] = (bf16)(v1.z & 0xffffu); Vt[(8 * dg + 5) * PV_ + s] = (bf16)(v1.z >> 16); Vt[(8 * dg + 6) * PV_ + s] = (bf16)(v1.w & 0xffffu); Vt[(8 * dg + 7) * PV_ + s] = (bf16)(v1.w >> 16); }
    __syncthreads();
    { const int dt = wid >> 1, fr = lane & 15, q4 = lane >> 4; f32x4 acc[2] = {(f32x4){0.f, 0.f, 0.f, 0.f}, (f32x4){0.f, 0.f, 0.f, 0.f}};
#pragma unroll
      for (int ks = 0; ks < 4; ++ks) { const bf16x8 a = *(const LAS bf16x8*)(Ktw + (16 * dt + fr) * PV_ + 32 * ks + 8 * q4);
#pragma unroll
          for (int et = 0; et < 2; ++et) { const bf16x8 bb = *(const LAS bf16x8*)(Vt + (16 * (2 * (wid & 1) + et) + fr) * PV_ + 32 * ks + 8 * q4); acc[et] = __builtin_amdgcn_mfma_f32_16x16x32_bf16(a, bb, acc[et], 0, 0, 0); } }
      float* dp = DLOC + ((size_t)(bh * NC + c) * 64) * 64;
#pragma unroll
      for (int et = 0; et < 2; ++et) *(f32x4*)(dp + (16 * (2 * (wid & 1) + et) + fr) * 64 + 16 * dt + 4 * q4) = acc[et]; }
    { const int d = tid & 63, part = tid >> 6; const v4u k0 = *(const LAS v4u*)(Ktw + d * PV_ + 16 * part), k1 = *(const LAS v4u*)(Ktw + d * PV_ + 16 * part + 8);
      float s = ((bf2f(k0.x) + bf2f(k0.x >> 16)) + (bf2f(k0.y) + bf2f(k0.y >> 16))) + ((bf2f(k0.z) + bf2f(k0.z >> 16)) + (bf2f(k0.w) + bf2f(k0.w >> 16)));
      s += ((bf2f(k1.x) + bf2f(k1.x >> 16)) + (bf2f(k1.y) + bf2f(k1.y >> 16))) + ((bf2f(k1.z) + bf2f(k1.z >> 16)) + (bf2f(k1.w) + bf2f(k1.w >> 16)));
      F[F_G + part * 64 + d] = s; }
    __syncthreads();
    if (tid < 64) { float s = 0.f;
#pragma unroll
        for (int p = 0; p < 8; ++p) s += F[F_G + p * 64 + tid];
        NLOC[(size_t)(bh * NC + c) * 64 + tid] = s; }
    if (tid == 64) { SCAL[(bh * NC + c) * 2] = gl; SCAL[(bh * NC + c) * 2 + 1] = mloc; }
    __syncthreads();
}
__device__ __forceinline__ void unit_b4(int bh, int part, const float* __restrict__ DLOC, const float* __restrict__ NLOC, const float* __restrict__ SCAL, bf16* __restrict__ CT, float* __restrict__ NPREV, float* __restrict__ MPREV,
                                        LAS float* sc  , const int tid) {
    const bool isC = part < 8, isN = !isC && tid < 64, on = isC || isN;
    if (tid < 128) sc[tid] = SCAL[bh * NC * 2 + tid];
    const float* src = isC ? DLOC + (size_t)bh * NC * 4096 + part * 512 + tid : NLOC + (size_t)bh * NC * 64 + (isN ? tid : 0);
    const int stride = isC ? 4096 : 64;
    float dv[NC];
#pragma unroll
    for (int c = 0; c < NC; ++c) dv[c] = on ? src[(size_t)c * stride] : 0.f;
    __syncthreads();
    LAS float* ab = sc + 128; LAS float* mv = sc + 256;
    if (tid < 64) { const float gl = sc[2 * tid], mloc = sc[2 * tid + 1]; float A = gl, B = mloc;
#pragma unroll
        for (int o = 1; o < 64; o <<= 1) { const float Ap = __shfl_up(A, o), Bp = __shfl_up(B, o); if (tid >= o) { B = fmaxf(Bp + A, B); A = Ap + A; } }
        const float mc = fmaxf(A, B); float mp = __shfl_up(mc, 1); if (tid == 0) mp = 0.f;
        ab[2 * tid] = __expf(gl + mp - mc); ab[2 * tid + 1] = __expf(mloc - mc); mv[tid] = mp; }
    __syncthreads();
    float st = 0.f;
    const LAS float* abv = ab; asm volatile("" : "+v"(abv));
    if (isC) {
        bf16* cp = CT + (size_t)(bh * NC) * 4096 + part * 512 + tid;
#pragma unroll
        for (int c = 0; c < NC; ++c) { cp[(size_t)c * 4096] = (bf16)f2bf(st); st = abv[2 * c] * st + abv[2 * c + 1] * dv[c]; }
    } else if (isN) {
        float* np_ = NPREV + (size_t)(bh * NC) * 64 + tid;
#pragma unroll
        for (int c = 0; c < NC; ++c) { np_[c * 64] = st; if (tid == 0) MPREV[bh * NC + c] = abv[128 + c]; st = abv[2 * c] * st + abv[2 * c + 1] * dv[c]; }
    }
    __syncthreads();
}
__device__ __forceinline__ void unit_c(int bh, int c, int l, const bf16* __restrict__ Z, const float* __restrict__ gates, const float* __restrict__ mconv, const float* __restrict__ ng,
                                       const bf16* __restrict__ CT, const float* __restrict__ NPREV, const float* __restrict__ MPREV, bf16* __restrict__ mix, LAS unsigned char* shm, const int tid) {
    const int lane = tid & 63, wid = __builtin_amdgcn_readfirstlane(tid >> 6), b = bh >> 2, h = bh & 3, fr = lane & 15, q4 = lane >> 4;
    const long row0 = (long)b * SEQ + (long)c * L;
    LAS float* F = (LAS float*)(shm + O_F); LAS bf16* Qs = (LAS bf16*)(shm + O_QS); LAS bf16* Ks = (LAS bf16*)(shm + O_KS); LAS bf16* Vt = (LAS bf16*)(shm + O_VT); LAS bf16* Ct = (LAS bf16*)(shm + O_CT);
    const float mprev = MPREV[bh * NC + c];
    v4u zq[2][4], zk[2][4], vv[2];
#pragma unroll
    for (int i = 0; i < 2; ++i) { const int item = tid + 512 * i, s = item >> 3, dg = item & 7;
        conv8_load(Z + (row0 + s) * ZP + ZC_MQ + 64 * h + 8 * dg, c * L + s, zq[i]); conv8_load(Z + (row0 + s) * ZP + ZC_MK + 64 * h + 8 * dg, c * L + s, zk[i]);
        vv[i] = *(const v4u*)(Z + (row0 + s) * ZP + ZC_MV + 64 * h + 8 * dg); }
    const v4u ctv = *(const v4u*)(CT + (size_t)(bh * NC + c) * 4096 + (tid >> 3) * 64 + (tid & 7) * 8);
    float gs = 0.f, us = 0.f, bm = 0.f;
    if (tid < 128) { const float ip = gates[(row0 + tid) * 8 + h], fp = gates[(row0 + tid) * 8 + 4 + h]; gs = scan_add64(logsig_(fp), lane); us = ip; if (tid == 63) F[F_TMP] = gs; }
    else if (tid < 192) F[F_NP + (tid - 128)] = NPREV[(size_t)(bh * NC + c) * 64 + (tid - 128)];
    __syncthreads();
    if (tid < 128) { if (tid >= 64) gs += F[F_TMP]; us -= gs; bm = scan_max64(us, lane); if (tid == 63) F[F_TMP + 1] = bm; }
    __syncthreads();
    if (tid < 128) { if (tid >= 64) bm = fmaxf(bm, F[F_TMP + 1]); const float Mt = fmaxf(mprev, bm);
        F[F_G + tid] = gs; F[F_U + tid] = us * LOG2E; F[F_M + tid] = Mt * LOG2E; F[F_A + tid] = __expf(mprev - Mt); F[F_E + tid] = __expf(-(gs + Mt)); }
#pragma unroll
    for (int i = 0; i < 2; ++i) { const int item = tid + 512 * i, s = item >> 3, dg = item & 7; float y[8];
        conv8_math(zq[i], c * L + s, mconv + 64 * h + 8 * dg, y);
        v4u o; o.x = pk2(y[0], y[1]); o.y = pk2(y[2], y[3]); o.z = pk2(y[4], y[5]); o.w = pk2(y[6], y[7]); *(LAS v4u*)(Qs + s * PQ + 8 * dg) = o;
        conv8_math(zk[i], c * L + s, mconv + 256 + 64 * h + 8 * dg, y);
        o.x = pk2(y[0] * 0.125f, y[1] * 0.125f); o.y = pk2(y[2] * 0.125f, y[3] * 0.125f); o.z = pk2(y[4] * 0.125f, y[5] * 0.125f); o.w = pk2(y[6] * 0.125f, y[7] * 0.125f); *(LAS v4u*)(Ks + s * PQ + 8 * dg) = o;
        const v4u v1 = vv[i];
        Vt[(8 * dg + 0) * PV_ + s] = (bf16)(v1.x & 0xffffu); Vt[(8 * dg + 1) * PV_ + s] = (bf16)(v1.x >> 16); Vt[(8 * dg + 2) * PV_ + s] = (bf16)(v1.y & 0xffffu); Vt[(8 * dg + 3) * PV_ + s] = (bf16)(v1.y >> 16);
        Vt[(8 * dg + 4) * PV_ + s] = (bf16)(v1.z & 0xffffu); Vt[(8 * dg + 5) * PV_ + s] = (bf16)(v1.z >> 16); Vt[(8 * dg + 6) * PV_ + s] = (bf16)(v1.w & 0xffffu); Vt[(8 * dg + 7) * PV_ + s] = (bf16)(v1.w >> 16); }
    { const int e = tid >> 3, d8 = (tid & 7) * 8; *(LAS v4u*)(Ct + e * PQ + d8) = ctv; }
    __syncthreads();
    if (tid < 128) { float s = 0.f;
#pragma unroll 8
        for (int d = 0; d < 64; ++d) s += bf2f(Qs[tid * PQ + d]) * F[F_NP + d];
        F[F_QN + tid] = s; }
    const int w = wid; const int tl = 16 * w + fr;
    bf16x8 qf[2];
#pragma unroll
    for (int ks = 0; ks < 2; ++ks) qf[ks] = *(const LAS bf16x8*)(Qs + tl * PQ + 32 * ks + 8 * q4);
    const float M2 = F[F_M + tl];
    f32x4 num[4] = {(f32x4){0.f, 0.f, 0.f, 0.f}, (f32x4){0.f, 0.f, 0.f, 0.f}, (f32x4){0.f, 0.f, 0.f, 0.f}, (f32x4){0.f, 0.f, 0.f, 0.f}};
    float dsum = 0.f;
    for (int i = 0; i <= (w >> 1); ++i) {
        unsigned pw[4];
#pragma unroll
        for (int hf = 0; hf < 2; ++hf) { const int j = 2 * i + hf; f32x4 sv = (f32x4){0.f, 0.f, 0.f, 0.f};
            if (j <= w) {
#pragma unroll
                for (int ks = 0; ks < 2; ++ks) { const bf16x8 kf = *(const LAS bf16x8*)(Ks + (16 * j + fr) * PQ + 32 * ks + 8 * q4); sv = __builtin_amdgcn_mfma_f32_16x16x32_bf16(kf, qf[ks], sv, 0, 0, 0); }
                const f32x4 u2 = *(const LAS f32x4*)(F + F_U + 16 * j + 4 * q4);
#pragma unroll
                for (int r = 0; r < 4; ++r) { float wv = sv[r] * __builtin_amdgcn_exp2f(u2[r] - M2); if (j == w && 4 * q4 + r > fr) wv = 0.f; sv[r] = wv; dsum += wv; } }
            pw[2 * hf] = pg8::cvtpk(sv[0], sv[1]); pw[2 * hf + 1] = pg8::cvtpk(sv[2], sv[3]); }
        const bf16x8 wa = __builtin_bit_cast(bf16x8, (v4u){pw[0], pw[1], pw[2], pw[3]});
#pragma unroll
        for (int et = 0; et < 4; ++et) { const bf16x4 v0 = *(const LAS bf16x4*)(Vt + (16 * et + fr) * PV_ + 32 * i + 4 * q4), v1 = *(const LAS bf16x4*)(Vt + (16 * et + fr) * PV_ + 32 * i + 16 + 4 * q4);
            const bf16x8 vb = (bf16x8){v0[0], v0[1], v0[2], v0[3], v1[0], v1[1], v1[2], v1[3]};
            num[et] = __builtin_amdgcn_mfma_f32_16x16x32_bf16(wa, vb, num[et], 0, 0, 0); }
    }
    dsum += __shfl_xor(dsum, 16); dsum += __shfl_xor(dsum, 32);
    __syncthreads();
    if (q4 == 0) F[F_DEN + tl] = dsum + F[F_A + tl] * F[F_QN + tl];
    f32x4 inter[4];
#pragma unroll
    for (int et = 0; et < 4; ++et) { inter[et] = (f32x4){0.f, 0.f, 0.f, 0.f};
#pragma unroll
        for (int ks = 0; ks < 2; ++ks) { const bf16x8 cf = *(const LAS bf16x8*)(Ct + (16 * et + fr) * PQ + 32 * ks + 8 * q4); inter[et] = __builtin_amdgcn_mfma_f32_16x16x32_bf16(qf[ks], cf, inter[et], 0, 0, 0); } }
    asm volatile("s_waitcnt lgkmcnt(0)" ::: "memory");
    LAS float* stg = (LAS float*)(shm + O_STG) + w * 1024;
#pragma unroll
    for (int r = 0; r < 4; ++r) { const int t = 16 * w + 4 * q4 + r; const float a = F[F_A + t], den = F[F_DEN + t], dn = __builtin_amdgcn_rcpf(fmaxf(fabsf(den), F[F_E + t]));
        float hv[4], ss = 0.f;
#pragma unroll
        for (int et = 0; et < 4; ++et) { hv[et] = (num[et][r] + a * inter[et][r]) * dn; ss += hv[et] * hv[et]; }
        ss = pg8::rowsum16(ss);
        const float rn = rsqrtf(ss * (1.f / 64.f) + 1e-6f);
#pragma unroll
        for (int et = 0; et < 4; ++et) stg[(4 * q4 + r) * 64 + 16 * et + fr] = hv[et] * rn; }
    asm volatile("s_waitcnt lgkmcnt(0)" ::: "memory");
#pragma unroll
    for (int p = 0; p < 2; ++p) { const int rr = 8 * p + (lane >> 3), e8 = (lane & 7) * 8; const long row = row0 + 16 * w + rr;
        const f32x4 h0 = *(const LAS f32x4*)(stg + rr * 64 + e8), h1 = *(const LAS f32x4*)(stg + rr * 64 + e8 + 4);
        const f32x4 g0 = *(const f32x4*)(ng + 64 * h + e8), g1 = *(const f32x4*)(ng + 64 * h + e8 + 4);
        const v4u og = *(const v4u*)(Z + row * ZP + ZC_MO + 64 * h + e8);
        v4u o; o.x = pk2(h0.x * g0.x * bf2f(og.x), h0.y * g0.y * bf2f(og.x >> 16)); o.y = pk2(h0.z * g0.z * bf2f(og.y), h0.w * g0.w * bf2f(og.y >> 16));
        o.z = pk2(h1.x * g1.x * bf2f(og.z), h1.y * g1.y * bf2f(og.z >> 16)); o.w = pk2(h1.z * g1.z * bf2f(og.w), h1.w * g1.w * bf2f(og.w >> 16));
        *(v4u*)(mix + row * DM + MC_ML + 64 * h + e8) = o; }
    __syncthreads();
}
}

namespace poolx {
typedef short bf16x8 __attribute__((ext_vector_type(8)));
typedef float f32x4 __attribute__((ext_vector_type(4)));
constexpr int TOK = 64, HALO = 15, PIN = 264, PPW = 72;
constexpr int O_IN = 0, O_PW = 41728, O_OUT = O_PW + 4 * 64 * PPW * 2, LDS_NEED = O_OUT + TOK * PIN * 2;
__device__ __forceinline__ void unit(int u, const bf16* __restrict__ Z, const bf16* __restrict__ PWT, const float* __restrict__ pscale, bf16* __restrict__ mix, LAS unsigned char* shm, const int tid) {
    const int lane = tid & 63, wid = __builtin_amdgcn_readfirstlane(tid >> 6), fr = lane & 15, q4 = lane >> 4;
    const long row0 = (long)u * TOK; const int tpos0 = (int)(row0 % SEQ);
    LAS bf16* ins = (LAS bf16*)(shm + O_IN); LAS bf16* pws = (LAS bf16*)(shm + O_PW); LAS bf16* outs = (LAS bf16*)(shm + O_OUT);
    { v4u zin[5], pwv[4];
#pragma unroll
      for (int k = 0; k < 5; ++k) { const int it = tid + 512 * k, rr = it >> 5, ch = it & 31; const bool ok = it < (TOK + HALO) * 32 && tpos0 - HALO + rr >= 0;
          zin[k] = *(const v4u*)(Z + (ok ? row0 - HALO + rr : row0) * ZP + ZC_POOL + 8 * ch); if (!ok) zin[k] = (v4u){0u, 0u, 0u, 0u}; }
#pragma unroll
      for (int k = 0; k < 4; ++k) { const int it = tid + 512 * k, ro = it >> 3, ch = it & 7; pwv[k] = *(const v4u*)(PWT + ro * 64 + 8 * ch); }
#pragma unroll
      for (int k = 0; k < 5; ++k) { const int it = tid + 512 * k, rr = it >> 5, ch = it & 31; if (it < (TOK + HALO) * 32) *(LAS v4u*)(ins + rr * PIN + 8 * ch) = zin[k]; }
#pragma unroll
      for (int k = 0; k < 4; ++k) { const int it = tid + 512 * k, ro = it >> 3, ch = it & 7; *(LAS v4u*)(pws + ro * PPW + 8 * ch) = pwv[k]; } }
    __syncthreads();
    const int tt = wid & 3, gp = wid >> 2, tloc = 16 * tt + fr, tpos = tpos0 + tloc;
    float scv[2][4];
#pragma unroll
    for (int gi = 0; gi < 2; ++gi)
#pragma unroll
        for (int ot = 0; ot < 4; ++ot) scv[gi][ot] = pscale[64 * (gp == 0 ? 3 * gi : 1 + gi) + 16 * ot + fr];
#pragma unroll
    for (int gi = 0; gi < 2; ++gi) { const int g = gp == 0 ? 3 * gi : 1 + gi  , win = 2 << g; const int cnt = (tpos + 1) < win ? (tpos + 1) : win; const float inv = 1.f / (float)cnt;
        bf16x8 af[2];
#pragma unroll
        for (int ks = 0; ks < 2; ++ks) { const LAS bf16* p = ins + (HALO + tloc) * PIN + 64 * g + 32 * ks + 8 * q4; float s[8];
            const v4u x0 = *(const LAS v4u*)p;
#pragma unroll
            for (int j = 0; j < 8; ++j) s[j] = 0.f;
#pragma unroll 4
            for (int i = 0; i < win; ++i) { const v4u v = *(const LAS v4u*)(p - i * PIN);
                s[0] += bf2f(v.x); s[1] += bf2f(v.x >> 16); s[2] += bf2f(v.y); s[3] += bf2f(v.y >> 16); s[4] += bf2f(v.z); s[5] += bf2f(v.z >> 16); s[6] += bf2f(v.w); s[7] += bf2f(v.w >> 16); }
            v4u o; o.x = pk2(s[0] * inv - bf2f(x0.x), s[1] * inv - bf2f(x0.x >> 16)); o.y = pk2(s[2] * inv - bf2f(x0.y), s[3] * inv - bf2f(x0.y >> 16));
            o.z = pk2(s[4] * inv - bf2f(x0.z), s[5] * inv - bf2f(x0.z >> 16)); o.w = pk2(s[6] * inv - bf2f(x0.w), s[7] * inv - bf2f(x0.w >> 16));
            af[ks] = __builtin_bit_cast(bf16x8, o); }
#pragma unroll
        for (int ot = 0; ot < 4; ++ot) { f32x4 acc = (f32x4){0.f, 0.f, 0.f, 0.f};
#pragma unroll
            for (int ks = 0; ks < 2; ++ks) { const bf16x8 bfr = *(const LAS bf16x8*)(pws + (64 * g + 16 * ot + fr) * PPW + 32 * ks + 8 * q4); acc = __builtin_amdgcn_mfma_f32_16x16x32_bf16(af[ks], bfr, acc, 0, 0, 0); }
            const float sc = scv[gi][ot];
#pragma unroll
            for (int r = 0; r < 4; ++r) outs[(16 * tt + 4 * q4 + r) * PIN + 64 * g + 16 * ot + fr] = (bf16)f2bf(acc[r] * sc); } }
    __syncthreads();
    for (int it = tid; it < TOK * 32; it += 512) { const int rr = it >> 5, ch = it & 31; *(v4u*)(mix + (row0 + rr) * DM + MC_POOL + 8 * ch) = *(const LAS v4u*)(outs + rr * PIN + 8 * ch); }
    __syncthreads();
}
}

constexpr int NWAVES = 8;
constexpr int RING_OFF = 0, RING_BYTES = 131072;
constexpr int LDSCTL_OFF = RING_BYTES, MISC_OFF = LDSCTL_OFF + 320;
constexpr int LDS_BYTES = 147456 + 2048;
constexpr int CW_CONV = 20480;
constexpr int CW_SEL = 16384;
constexpr int CW_BAR = 4096;
constexpr size_t CTL_ZERO_BYTES = 128 * 1024;
constexpr int N_PHASES = 1 + 7 * DEPTH;
enum { PK_IN = 0, PK_MIX1 = 1, PK_ATT = 2, PK_MLC = 3, PK_OUT = 4, PK_UP = 5, PK_DOWN = 6 };

#ifndef SKIP_PK_IN
#define SKIP_PK_IN 0
#endif
#ifndef SKIP_PK_OUT
#define SKIP_PK_OUT 0
#endif
#ifndef SKIP_PK_UP
#define SKIP_PK_UP 0
#endif
#ifndef SKIP_PK_DOWN
#define SKIP_PK_DOWN 0
#endif
#ifdef PROBE_KIND
#ifndef PROBE_KIND2
#define PROBE_KIND2 PROBE_KIND
#endif
#endif
#ifndef STAGGER_TICKS
#define STAGGER_TICKS 1200ull
#endif
#ifndef SPARSE_ATT
#define SPARSE_ATT 1
#endif
struct Args { const float* in[16]; float* out; unsigned char* ws; int ph_lo, ph_hi; };

struct PItem { const float* W; const float* gain; bf16* out; int K, Norig, r0, k0, mode; bool on; };
__device__ __forceinline__ void pw_load(const PItem& p, int tid, float (&v)[16]) {
    const int rr = p.r0 + (tid & 63); const int oc = p.mode == 0 ? in_orig_col(in_row_to_zc(rr)) : (p.mode == 2 ? up_row_to_orig(rr) : rr); const int occ = oc < 0 ? 0 : oc;
    const float* wp = p.W + (size_t)(p.k0 + (tid >> 6)) * p.Norig + occ;
#pragma unroll
    for (int i = 0; i < 16; ++i) v[i] = wp[(size_t)(4 * i) * p.Norig];
    if (p.gain) {
#pragma unroll
        for (int i = 0; i < 16; ++i) v[i] *= p.gain[p.k0 + (tid >> 6) + 4 * i]; }
    if (oc < 0) {
#pragma unroll
        for (int i = 0; i < 16; ++i) v[i] = 0.f; }
}
__device__ __forceinline__ void pw_store(const PItem& p, LAS float* t, int tid, const float (&v)[16]) {
#pragma unroll
    for (int i = 0; i < 16; ++i) t[((tid >> 6) + 4 * i) * 65 + (tid & 63)] = v[i];
    __syncthreads();
    if (p.on) {
#pragma unroll
    for (int it = 0; it < 2; ++it) { const int r = (tid >> 3) + 32 * it, k8 = (tid & 7) * 8; v4u o;
        o.x = pk2(t[(k8 + 0) * 65 + r], t[(k8 + 1) * 65 + r]); o.y = pk2(t[(k8 + 2) * 65 + r], t[(k8 + 3) * 65 + r]); o.z = pk2(t[(k8 + 4) * 65 + r], t[(k8 + 5) * 65 + r]); o.w = pk2(t[(k8 + 6) * 65 + r], t[(k8 + 7) * 65 + r]);
        *(v4u*)(p.out + (size_t)(p.r0 + r) * p.K + p.k0 + k8) = o; } }
    __syncthreads();
}

__global__ void __launch_bounds__(NWAVES * 64, 2) mk_fwd(Args args) {
    extern __shared__ __attribute__((aligned(16))) unsigned char lds_raw[];
    LAS unsigned char* lds = (LAS unsigned char*)lds_raw;
    constexpr int GA = 256, G = 128;
    gu32* ctl = (gu32*)(args.ws + WS_CTL);
    for (int u = threadIdx.x; u < (LDS_BYTES - LDSCTL_OFF) / 4; u += NWAVES * 64) ((LAS unsigned*)(lds + LDSCTL_OFF))[u] = 0u;
    __syncthreads();
    const int hs = (int)(blockIdx.x & 1);
    XcdBarrier bar_all = xcd_barrier_post((unsigned*)(ctl + CW_BAR), (volatile LAS unsigned*)(lds + MISC_OFF) + 8, 256u);
    XcdBarrier bar = xcd_barrier_post((unsigned*)(ctl + CW_BAR) + (1 + hs) * XCD_BAR_WORDS, (volatile LAS unsigned*)(lds + MISC_OFF) + 10, 128u);

    int prep_ = 0; (void)prep_;
    for (int ph = args.ph_lo; ph < args.ph_hi; ) {
        int tid = threadIdx.x; asm volatile("" : "+v"(tid));
        const int lane = tid & 63, wave = __builtin_amdgcn_readfirstlane(tid >> 6);
        int bx = blockIdx.x; asm volatile("" : "+s"(bx));
        int zi = 0; asm volatile("" : "+s"(zi));
        unsigned char* ws = args.ws + zi;
    const float* x = args.in[0 + zi]; const float* ln1 = args.in[1 + zi]; const float* w_in = args.in[2 + zi]; const float* pool_w = args.in[3 + zi]; const float* pool_scale = args.in[4 + zi];
    const float* m_conv = args.in[5 + zi]; const float* m_b_i = args.in[6 + zi]; const float* m_b_f = args.in[7 + zi]; const float* m_norm_g = args.in[8 + zi]; const float* a_q_g = args.in[9 + zi];
    const float* a_k_g = args.in[10 + zi]; const float* w_out = args.in[11 + zi]; const float* ln2 = args.in[12 + zi]; const float* w_up = args.in[13 + zi]; const float* ffn_conv = args.in[14 + zi]; const float* w_down = args.in[15 + zi];
    float* X = args.out + zi;
    bf16* Win = (bf16*)(ws + WS_WIN); bf16* Wout = (bf16*)(ws + WS_WOUT); bf16* Wup = (bf16*)(ws + WS_WUP); bf16* Wdown = (bf16*)(ws + WS_WDOWN);
    bf16* XB = (bf16*)(ws + WS_XB); bf16* Z = (bf16*)(ws + WS_Z); bf16* HACT = Z; bf16* MIX = (bf16*)(ws + WS_MIX);
    float* GATES = (float*)(ws + WS_GATES); float* ROWSQ = (float*)(ws + WS_ROWSQ); float* KPART = (float*)(ws + WS_KPART);
    float* DLOC = (float*)(ws + WS_DLOC); bf16* CT = (bf16*)(ws + WS_CT); float* NLOC = (float*)(ws + WS_NLOC); float* NPREV = (float*)(ws + WS_NPREV); float* SCAL = (float*)(ws + WS_SCAL); float* MPREV = (float*)(ws + WS_MPREV);
    bf16* PWT = (bf16*)(ws + WS_PWT); unsigned* LIST = (unsigned*)(ws + WS_LIST); bf16* PARTO = (bf16*)(ws + WS_PARTO); float* PARTL = (float*)(ws + WS_PARTL); unsigned* SELCNT = (unsigned*)(ws + WS_CTL) + CW_SEL;
    const int h = bx & 1, rk = bx >> 1;
    const int vcu = (rk % 4) * (G / 4) + rk / 4;

        if (ph == 0) {
            constexpr int I_IN = (NIN / 64) * (DM / 64), I_OUT = (DM / 64) * (DM / 64), I_UP = (NUP / 64) * (DM / 64), I_DOWN = (DM / 64) * (DFF / 64), I_L = I_IN + I_OUT + I_UP + I_DOWN, NITEMS = DEPTH * I_L;
            const int half = tid >> 8, t256 = tid & 255; LAS float* tl = (LAS float*)(lds + RING_OFF) + half * (64 * 65);
            auto decode = [&](int it) { PItem p; p.on = it < NITEMS; const int l = p.on ? it / I_L : 0; int r = p.on ? it % I_L : 0;
                if (r < I_IN) { p.W = w_in + (size_t)l * DM * IN_W; p.gain = ln1 + l * DM; p.out = Win + (size_t)l * NIN * DM; p.K = DM; p.Norig = IN_W; p.r0 = 64 * (r % (NIN / 64)); p.k0 = 64 * (r / (NIN / 64)); p.mode = 0; return p; } r -= I_IN;
                if (r < I_OUT) { p.W = w_out + (size_t)l * DM * DM; p.gain = nullptr; p.out = Wout + (size_t)l * DM * DM; p.K = DM; p.Norig = DM; p.r0 = 64 * (r % 16); p.k0 = 64 * (r / 16); p.mode = 1; return p; } r -= I_OUT;
                if (r < I_UP) { p.W = w_up + (size_t)l * DM * NUP; p.gain = ln2 + l * DM; p.out = Wup + (size_t)l * NUP * DM; p.K = DM; p.Norig = NUP; p.r0 = 64 * (r % (NUP / 64)); p.k0 = 64 * (r / (NUP / 64)); p.mode = 2; return p; } r -= I_UP;
                p.W = w_down + (size_t)l * DFF * DM; p.gain = nullptr; p.out = Wdown + (size_t)l * DM * DFF; p.K = DFF; p.Norig = DM; p.r0 = 64 * (r % 16); p.k0 = 64 * (r / 16); p.mode = 1; return p; };
            auto convert = [&](int first, int last, int wg, int nwg) {
                PItem cur = decode(first + 2 * wg + half); if (first + 2 * wg + half >= last) cur.on = false; float v[16]; pw_load(cur, t256, v);
                for (int it0 = first; it0 < last; it0 += 2 * nwg) {
                    const int itn = it0 + 2 * nwg + 2 * wg + half; PItem nxt = decode(itn); if (itn >= last) nxt.on = false; float vn[16]; pw_load(nxt, t256, vn);
                    pw_store(cur, tl, t256, v); cur = nxt;
#pragma unroll
                    for (int i = 0; i < 16; ++i) v[i] = vn[i]; } };
            for (int i = bx * 512 + tid; i < DEPTH * 4 * 4096; i += GA * 512) { const int lg = i >> 12, o = (i >> 6) & 63, c = i & 63; PWT[i] = (bf16)f2bf(pool_w[(size_t)lg * 4096 + c * 64 + o]); }
            const int vbx = (bx & 7) * (GA / 8) + (bx >> 3);
            for (int row = vbx * NWAVES + wave; row < M; row += 2 * GA * NWAVES) { f32x4 xv[2][4];
#pragma unroll
                for (int q = 0; q < 2; ++q)
#pragma unroll
                    for (int j = 0; j < 4; ++j) xv[q][j] = *(const f32x4*)(x + (size_t)(row + q * GA * NWAVES) * DM + 256 * j + 4 * lane);
#pragma unroll
                for (int q = 0; q < 2; ++q) { const size_t rw = row + q * GA * NWAVES; float s = 0.f;
#pragma unroll
                    for (int j = 0; j < 4; ++j) { const f32x4 v = xv[q][j];
                        s += v.x * v.x + v.y * v.y + v.z * v.z + v.w * v.w; uint2 o; o.x = pk2(v.x, v.y); o.y = pk2(v.z, v.w); *(uint2*)(XB + rw * DM + 256 * j + 4 * lane) = o; }
                    s = wave_sum(s); if (lane < 4) ROWSQ[rw * 4 + lane] = lane == 0 ? s : 0.f; } }
            for (int pass = 0; pass < 2; ++pass) {
                if (pass == 1) { XcdBarrier bl = bar_all; bl.bar += zi; bl.x += (unsigned)zi; xcd_barrier(bl); }
                constexpr int N0 = 2048;
                convert(pass ? (h ? I_L + N0 : I_L) : 0, pass ? (h ? NITEMS : I_L + N0) : I_L, pass ? vcu : vbx, pass ? G : GA);
                if (pass == 1) { asm volatile("s_waitcnt vmcnt(0)" ::: "memory"); __syncthreads();
                    if (tid == 0) { __builtin_amdgcn_fence(__ATOMIC_RELEASE, "agent"); asm volatile("s_waitcnt vmcnt(0)" ::: "memory"); __hip_atomic_fetch_add((unsigned*)(ctl + CW_CONV), 1u, __ATOMIC_RELAXED, __HIP_MEMORY_SCOPE_AGENT); } } }
        } else {
            const int l = (ph - 1) / 7, kind = (ph - 1) % 7;
            if (ph == 8) {
                if (tid == 0) { unsigned sp = 0; while (__hip_atomic_load((unsigned*)(ctl + CW_CONV), __ATOMIC_RELAXED, __HIP_MEMORY_SCOPE_AGENT) < 256u && ++sp < (1u << 22)) __builtin_amdgcn_s_sleep(8);
                    __builtin_amdgcn_fence(__ATOMIC_ACQUIRE, "agent"); asm volatile("s_waitcnt vmcnt(0)" ::: "memory"); }
                __syncthreads(); }
            {
            if (kind == PK_IN && !SKIP_PK_IN) {
                pg8::Gemm g{XB, Win + (size_t)l * NIN * DM, M, NIN, DM}; pg8::StaticOrder S; S.init(32, NIN / 256, G, rk, 4, 32 * h);
                pg8::EpiIn E{Z, GATES, KPART, ROWSQ, a_q_g + 64 * l, a_k_g + 64 * l, m_b_i + 4 * l, m_b_f + 4 * l};
                pg8::gemm_phase<pg8::EpiIn, pg8::StaticOrder, true, true>(lds + RING_OFF, g, S, E, tid);
            } else if (kind == PK_MIX1) {
                const int uA = vcu, uB = 247 - vcu, hA = uA / 31, hB = uB / 31; moba::SelKeep oA{0u, 0u}, oB{0u, 0u};
                if (vcu < 124) moba::sel_front(oA, oB, h, hA, 1 + (uA - 31 * hA), hB, 1 + (uB - 31 * hB), Z, KPART, SELCNT + l * 512, lds + RING_OFF, tid);
                int tidb = tid; asm volatile("" : "+v"(tidb));
                for (int u = vcu; u < 256; u += G) mlx::unit_a(4 * h + (u >> 6), u & 63, l, Z, GATES, m_conv + (size_t)l * 4 * 512, DLOC, NLOC, SCAL, lds + RING_OFF, tidb);
                asm volatile("" : "+v"(tidb));
                for (int u = vcu; u < 128; u += G) poolx::unit(128 * h + u, Z, PWT + (size_t)l * 4 * 4096, pool_scale + 256 * l, MIX, lds + RING_OFF, tidb);
                asm volatile("" : "+v"(tidb));
                if (vcu < 124) moba::sel_back(oA, oB, h, hA, 1 + (uA - 31 * hA), hB, 1 + (uB - 31 * hB), LIST, lds + RING_OFF, tidb);
            } else if (kind == PK_ATT) {
                LAS unsigned* pre = (LAS unsigned*)(lds + RING_OFF + 124 * 1024);
                { unsigned inc = 0u; if (tid < 256) { const unsigned c = SELCNT[l * 512 + 256 * h + tid]; inc = (c + 255u) >> 8; pre[600 + tid] = c; }
                  inc = mlx::wave_scan_add(inc);
                  if (lane == 63) pre[520 + wave] = inc;
                  __syncthreads();
                  unsigned woff = 0u; for (int w = 0; w < wave; ++w) woff += pre[520 + w];
                  if (tid < 256) pre[1 + tid] = inc + woff; if (tid == 0) pre[0] = 0u;
                  __syncthreads();
                  if (tid < 8) { const int u = vcu + tid * G; int lo = 0, hi2 = 256;
                      while (hi2 - lo > 1) { const int mid = (lo + hi2) >> 1; if ((int)pre[mid] <= u) lo = mid; else hi2 = mid; }
                      pre[900 + 4 * tid] = (unsigned)(256 * h + lo); pre[901 + 4 * tid] = (unsigned)(u - (int)pre[lo]); pre[902 + 4 * tid] = pre[600 + lo]; }
                  __syncthreads(); }
                const int total = (int)pre[256];
                moba::sparse_stream(vcu, G, total, h, pre, SELCNT + l * 512, Z, LIST, PARTO, PARTL, lds + RING_OFF, tid);
                if (vcu >= 92) mlx::unit_b4(4 * h + (vcu >= 96 ? (vcu - 96) >> 3 : vcu - 92), vcu >= 96 ? (vcu - 96) & 7 : 8, DLOC, NLOC, SCAL, CT, NPREV, MPREV, (LAS float*)(lds + RING_OFF + 120 * 1024), tid);
            } else if (kind == PK_MLC) {
                { const int p0 = vcu, p1 = vcu + G;
                  moba::own_unit<0, false, true>(h, p0 >> 5, p0 & 31, Z, PARTO, PARTL, MIX, lds + RING_OFF, tid, p1 >> 5, p1 & 31);
                  int tid2 = tid; asm volatile("" : "+v"(tid2));
                  moba::own_unit<moba::SLOTB, true, false>(h, p1 >> 5, p1 & 31, Z, PARTO, PARTL, MIX, lds + RING_OFF, tid2); }
                for (int u = vcu; u < 256; u += G) mlx::unit_c(4 * h + (u >> 6), u & 63, l, Z, GATES, m_conv + (size_t)l * 4 * 512, m_norm_g + 256 * l, CT, NPREV, MPREV, MIX, lds + RING_OFF, tid);
            } else if (kind == PK_OUT || kind == PK_DOWN) {
                const bool dn = kind == PK_DOWN;
                pg8::Gemm g{dn ? HACT : MIX, dn ? Wdown + (size_t)l * DM * DFF : Wout + (size_t)l * DM * DM, M, DM, dn ? DFF : DM}; pg8::StaticOrder S; S.init(32, DM / 256, G, rk, 4, 32 * h);
                pg8::EpiRes E{XB, ROWSQ, (dn && l == DEPTH - 1) ? X : nullptr};
                pg8::gemm_phase<pg8::EpiRes, pg8::StaticOrder, true, true>(lds + RING_OFF, g, S, E, tid);
            } else if (kind == PK_UP && !SKIP_PK_UP) {
                pg8::Gemm g{XB, Wup + (size_t)l * NUP * DM, M, NUP, DM}; pg8::UpOrder S; S.init(33, NUP / 256, G, rk, 4, 33 * h);
                pg8::EpiUp E{HACT, ROWSQ, ffn_conv + (size_t)l * 3 * NUP, (bf16*)(ws + WS_CTL + 512 * 1024)};
                pg8::gemm_phase<pg8::EpiUp, pg8::UpOrder, true, true>(lds + RING_OFF, g, S, E, tid);
            }
            }
        }
        if (ph == 0) {}
        else if (ph + 1 < args.ph_hi) { XcdBarrier bl = bar; bl.bar += zi; bl.x += (unsigned)zi; xcd_barrier(bl); }
        ++ph;
    }
}

extern "C" void kernel_launch(void* const* d_in, const int* in_sizes, int n_in, void* d_out, int out_size, void* d_ws, size_t ws_size, hipStream_t stream) {
    if (n_in != 16 || out_size != M * DM || ws_size < WS_END) { fprintf(stderr, "kernel_launch: unexpected shapes (n_in %d out %d ws %zu)\n", n_in, out_size, ws_size); return; }
    static int ready = 0;
    if (!ready) { int dev = 0, cus = 0; (void)hipGetDevice(&dev); (void)hipDeviceGetAttribute(&cus, hipDeviceAttributeMultiprocessorCount, dev);
        if (cus != 256) fprintf(stderr, "kernel_launch: built for a 256-CU device (one 512-thread workgroup per CU), found %d\n", cus);
        if (hipFuncSetAttribute((const void*)mk_fwd, hipFuncAttributeMaxDynamicSharedMemorySize, LDS_BYTES) != hipSuccess) { fprintf(stderr, "kernel_launch: hipFuncSetAttribute failed\n"); return; } ready = 1; }
    (void)hipMemsetAsync((unsigned char*)d_ws + WS_CTL, 0, CTL_ZERO_BYTES, stream);
    Args a{}; for (int i = 0; i < 16; ++i) a.in[i] = (const float*)d_in[i]; a.out = (float*)d_out; a.ws = (unsigned char*)d_ws;
#ifdef MULTI_LAUNCH
    for (int ph = 0; ph < N_PHASES; ++ph) { a.ph_lo = ph; a.ph_hi = ph + 1; hipLaunchKernelGGL(mk_fwd, dim3(256), dim3(NWAVES * 64), LDS_BYTES, stream, a); }
#else
    a.ph_lo = 0; a.ph_hi = N_PHASES; hipLaunchKernelGGL(mk_fwd, dim3(256), dim3(NWAVES * 64), LDS_BYTES, stream, a);
#endif
}
```
